# Optimizing an MI355X kernel written in HIP

```python
import math
import jax, jax.numpy as jnp
from jax import lax
import numpy as np

D_MODEL = 2048
BATCH = 4
SEQ = 4096
DEPTH = 4

CTX_LEN = 256
GRID_W = 64
Q_BLOCK = 128
ROPE_THETA = 10000.0
NORM_EPS = 1e-5

MLA_HEADS = 8
MLA_Q_LORA = 512
MLA_KV_LORA = 512
MLA_NOPE = 128
MLA_ROPE = 64
MLA_V = 128
MLA_QK = MLA_NOPE + MLA_ROPE

SGU_CHUNK = 128
SGU_GROUPS = 8
SGU_GROUP_W = 128
SGU_W = SGU_GROUPS * SGU_GROUP_W

DIFF_HEADS = 4
DIFF_HEAD_DIM = 128
DIFF_V = 2 * DIFF_HEAD_DIM

N_BRANCH = 3
BRANCH_W = 1024
FFN_HIDDEN = -(-8 * D_MODEL // (3 * 256)) * 256

IN_SIZES = [MLA_Q_LORA, MLA_KV_LORA, MLA_ROPE, 2 * SGU_W,
            DIFF_HEADS * 2 * DIFF_HEAD_DIM, DIFF_HEADS * 2 * DIFF_HEAD_DIM,
            DIFF_HEADS * DIFF_V, N_BRANCH * D_MODEL]
IN_W = int(sum(IN_SIZES))
IN_SPLITS = [int(s) for s in np.cumsum(IN_SIZES)[:-1]]

DEEPNORM_ALPHA = (2 * DEPTH) ** 0.25
DEEPNORM_BETA = (8 * DEPTH) ** -0.25

kernel_name = 'hybrid_mla_sgu_diffattn_deepnorm'


def layer_norm(x, g, b):
    xf = x.astype(jnp.float32)
    mu = jnp.mean(xf, axis=-1, keepdims=True)
    var = jnp.mean(jnp.square(xf - mu), axis=-1, keepdims=True)
    return ((xf - mu) * lax.rsqrt(var + NORM_EPS)).astype(x.dtype) * g + b


def rms_norm(x, g):
    xf = x.astype(jnp.float32)
    return (xf * lax.rsqrt(jnp.mean(xf * xf, axis=-1, keepdims=True) + NORM_EPS)).astype(x.dtype) * g


def axial_rope_tables(rows, dim, dtype):
    r = jnp.repeat(jnp.arange(rows, dtype=jnp.float32), GRID_W)
    col = jnp.tile(jnp.arange(GRID_W, dtype=jnp.float32), rows)
    quarter = dim // 4
    inv = ROPE_THETA ** (-jnp.arange(quarter, dtype=jnp.float32) / quarter)
    ar = r[:, None] * inv
    ac = col[:, None] * inv
    ang = jnp.concatenate([ar, ar, ac, ac], axis=-1)
    return jnp.cos(ang).astype(dtype), jnp.sin(ang).astype(dtype)


def apply_rope(x, cos, sin):
    xa = x.reshape(x.shape[:-1] + (2, 2, x.shape[-1] // 4))
    rot = jnp.stack([-xa[..., 1, :], xa[..., 0, :]], axis=-2).reshape(x.shape)
    return x * cos + rot * sin


def block_attention(q, k, v):
    B, H, Sq, dk = q.shape
    nb = Sq // Q_BLOCK
    scale = dk ** -0.5
    qb = q.reshape(B, H, nb, Q_BLOCK, dk).transpose(2, 0, 1, 3, 4)

    def one_block(qblk):
        s = jnp.einsum('bhqd,bhkd->bhqk', qblk, k, preferred_element_type=jnp.float32) * scale
        p = jax.nn.softmax(s, axis=-1).astype(v.dtype)
        return jnp.einsum('bhqk,bhkd->bhqd', p, v)

    o = lax.map(one_block, qb)
    return o.transpose(1, 2, 0, 3, 4).reshape(B, H, Sq, v.shape[-1])


def heads_to_tokens(o):
    B, H, S, d = o.shape
    return o.transpose(0, 2, 1, 3).reshape(B, S, H * d)


def mla_qkv(zq, zkv, zkr, q_norm, w_uq, kv_norm, w_ukv, rope):
    B, S, _ = zq.shape
    q = (rms_norm(zq, q_norm) @ w_uq).reshape(B, S, MLA_HEADS, MLA_QK).transpose(0, 2, 1, 3)
    kv = (rms_norm(zkv, kv_norm) @ w_ukv).reshape(B, S, MLA_HEADS, MLA_NOPE + MLA_V).transpose(0, 2, 1, 3)
    q_nope, q_rope = q[..., :MLA_NOPE], q[..., MLA_NOPE:]
    k_nope, v = kv[..., :MLA_NOPE], kv[..., MLA_NOPE:]
    k_rope = zkr[:, None]
    if rope is not None:
        cos, sin = rope
        q_rope = apply_rope(q_rope, cos, sin)
        k_rope = apply_rope(k_rope, cos, sin)
    q = jnp.concatenate([q_nope, q_rope], axis=-1)
    k = jnp.concatenate([k_nope, jnp.broadcast_to(k_rope, (B, MLA_HEADS, S, MLA_ROPE))], axis=-1)
    return q, k, v


def diff_qkv(zq, zk, zv, rope):
    B, S, _ = zq.shape
    q = zq.reshape(B, S, DIFF_HEADS, 2, DIFF_HEAD_DIM).transpose(3, 0, 2, 1, 4)
    k = zk.reshape(B, S, DIFF_HEADS, 2, DIFF_HEAD_DIM).transpose(3, 0, 2, 1, 4)
    if rope is not None:
        cos, sin = rope
        q = apply_rope(q, cos, sin)
        k = apply_rope(k, cos, sin)
    v = zv.reshape(B, S, DIFF_HEADS, DIFF_V).transpose(0, 2, 1, 3)
    return q, k, v


def diff_lambda(lp, lam_init):
    lpf = lp.astype(jnp.float32)
    return jnp.exp(jnp.sum(lpf[0] * lpf[1])) - jnp.exp(jnp.sum(lpf[2] * lpf[3])) + lam_init


def diff_combine(o1, o2, lam, subln_g, lam_init):
    o = rms_norm(o1 - lam * o2, subln_g) * (1.0 - lam_init)
    return heads_to_tokens(o)


def spatial_gating(z, ln_g, ln_b, w_s, b_s):
    B, S, _ = z.shape
    u, v = jnp.split(jax.nn.gelu(z), 2, axis=-1)
    v = layer_norm(v, ln_g, ln_b)
    vc = v.reshape(B, S // SGU_CHUNK, SGU_CHUNK, SGU_GROUPS, SGU_GROUP_W)
    s = jnp.einsum('gpq,bnqgc->bnpgc', w_s, vc) + b_s.T[:, :, None]
    return u * s.reshape(B, S, SGU_W)


def merge_branches(z_gate, ya, ys, yd, w_branch, w_out):
    gates = jax.nn.sigmoid(z_gate).reshape(z_gate.shape[:-1] + (N_BRANCH, D_MODEL))
    y = jnp.stack([ya, ys, yd], axis=-2)
    proj = jnp.einsum('bsnc,ncd->bsnd', y, w_branch)
    return jnp.sum(gates * proj, axis=-2) @ w_out


def swiglu(h, w_gu, w_down):
    gt, up = jnp.split(h @ w_gu, 2, axis=-1)
    return (jax.nn.silu(gt) * up) @ w_down


def setup_inputs(seed: int = 0) -> dict:
    key = jax.random.key(seed)
    ks = iter(jax.random.split(key, 32))
    L, D = DEPTH, D_MODEL
    beta = DEEPNORM_BETA

    def nrm(shape, s):
        return jax.random.normal(next(ks), shape, jnp.float32) * s

    return {
        'x': nrm((BATCH, SEQ, D), 1.0),
        'c': nrm((BATCH, D), 1.0),
        'ctx': nrm((BATCH, CTX_LEN, D), 1.0),
        'c_ctx': nrm((D,), 1.0),
        'ada_w': nrm((L, D, 6 * D), 0.5 * D ** -0.5),
        'ada_b': nrm((L, 6 * D), 0.02),
        'w_in': nrm((L, D, IN_W), D ** -0.5),
        'mla_q_norm': 1.0 + nrm((L, MLA_Q_LORA), 0.1),
        'mla_w_uq': nrm((L, MLA_Q_LORA, MLA_HEADS * MLA_QK), MLA_Q_LORA ** -0.5),
        'mla_kv_norm': 1.0 + nrm((L, MLA_KV_LORA), 0.1),
        'mla_w_ukv': nrm((L, MLA_KV_LORA, MLA_HEADS * (MLA_NOPE + MLA_V)), MLA_KV_LORA ** -0.5),
        'sgu_ln_g': 1.0 + nrm((L, SGU_W), 0.1),
        'sgu_ln_b': nrm((L, SGU_W), 0.02),
        'sgu_w': nrm((L, SGU_GROUPS, SGU_CHUNK, SGU_CHUNK), 0.5 * SGU_CHUNK ** -0.5),
        'sgu_b': 1.0 + nrm((L, SGU_GROUPS, SGU_CHUNK), 0.1),
        'diff_lam': nrm((L, 4, DIFF_HEAD_DIM), 0.1),
        'diff_subln': 1.0 + nrm((L, DIFF_V), 0.1),
        'w_branch': nrm((L, N_BRANCH, BRANCH_W, D), beta * BRANCH_W ** -0.5),
        'w_out': nrm((L, D, D), beta * D ** -0.5),
        'ln1_g': 1.0 + nrm((L, D), 0.1),
        'ln1_b': nrm((L, D), 0.02),
        'ffn_w_gu': nrm((L, D, 2 * FFN_HIDDEN), D ** -0.5),
        'ffn_w_down': nrm((L, FFN_HIDDEN, D), beta * FFN_HIDDEN ** -0.5),
        'ln2_g': 1.0 + nrm((L, D), 0.1),
        'ln2_b': nrm((L, D), 0.02),
    }


def reference(x, c, ctx, c_ctx, ada_w, ada_b, w_in, mla_q_norm, mla_w_uq, mla_kv_norm, mla_w_ukv,
              sgu_ln_g, sgu_ln_b, sgu_w, sgu_b, diff_lam, diff_subln, w_branch, w_out,
              ln1_g, ln1_b, ffn_w_gu, ffn_w_down, ln2_g, ln2_b):
    n_lat = x.shape[1]
    rows = n_lat // GRID_W
    rope_mla = axial_rope_tables(rows, MLA_ROPE, x.dtype)
    rope_diff = axial_rope_tables(rows, DIFF_HEAD_DIM, x.dtype)
    silu_c = jax.nn.silu(c)
    silu_cc = jax.nn.silu(c_ctx)
    h_lat, h_ctx = x, ctx
    for l in range(DEPTH):
        ctx_out = l < DEPTH - 1
        lam_init = 0.8 - 0.6 * math.exp(-0.3 * l)
        lam = diff_lambda(diff_lam[l], lam_init).astype(x.dtype)
        sh1, sc1, g1, sh2, sc2, g2 = jnp.split((silu_c @ ada_w[l] + ada_b[l])[:, None, :], 6, axis=-1)
        csh1, csc1, cg1, csh2, csc2, cg2 = jnp.split(silu_cc @ ada_w[l] + ada_b[l], 6, axis=-1)

        z_lat = jnp.split((h_lat * (1 + sc1) + sh1) @ w_in[l], IN_SPLITS, axis=-1)
        z_ctx = jnp.split((h_ctx * (1 + csc1) + csh1) @ w_in[l], IN_SPLITS, axis=-1)
        mla_w = (mla_q_norm[l], mla_w_uq[l], mla_kv_norm[l], mla_w_ukv[l])
        qa_l, ka_l, va_l = mla_qkv(z_lat[0], z_lat[1], z_lat[2], *mla_w, rope_mla)
        qa_c, ka_c, va_c = mla_qkv(z_ctx[0], z_ctx[1], z_ctx[2], *mla_w, None)
        qd_l, kd_l, vd_l = diff_qkv(z_lat[4], z_lat[5], z_lat[6], rope_diff)
        qd_c, kd_c, vd_c = diff_qkv(z_ctx[4], z_ctx[5], z_ctx[6], None)

        ya_l = heads_to_tokens(block_attention(qa_l, jnp.concatenate([ka_c, ka_l], axis=2),
                                               jnp.concatenate([va_c, va_l], axis=2)))
        kd_all = jnp.concatenate([kd_c, kd_l], axis=3)
        vd_all = jnp.concatenate([vd_c, vd_l], axis=2)
        yd_l = diff_combine(block_attention(qd_l[0], kd_all[0], vd_all),
                            block_attention(qd_l[1], kd_all[1], vd_all), lam, diff_subln[l], lam_init)
        ys_l = spatial_gating(z_lat[3], sgu_ln_g[l], sgu_ln_b[l], sgu_w[l], sgu_b[l])
        mix_lat = merge_branches(z_lat[7], ya_l, ys_l, yd_l, w_branch[l], w_out[l])

        if ctx_out:
            ya_c = heads_to_tokens(block_attention(qa_c, ka_c, va_c))
            yd_c = diff_combine(block_attention(qd_c[0], kd_c[0], vd_c),
                                block_attention(qd_c[1], kd_c[1], vd_c), lam, diff_subln[l], lam_init)
            ys_c = spatial_gating(z_ctx[3], sgu_ln_g[l], sgu_ln_b[l], sgu_w[l], sgu_b[l])
            mix_ctx = merge_branches(z_ctx[7], ya_c, ys_c, yd_c, w_branch[l], w_out[l])
            h_ctx = layer_norm(DEEPNORM_ALPHA * h_ctx + cg1 * mix_ctx, ln1_g[l], ln1_b[l])
            ff_ctx = swiglu(h_ctx * (1 + csc2) + csh2, ffn_w_gu[l], ffn_w_down[l])
            h_ctx = layer_norm(DEEPNORM_ALPHA * h_ctx + cg2 * ff_ctx, ln2_g[l], ln2_b[l])

        h_lat = layer_norm(DEEPNORM_ALPHA * h_lat + g1 * mix_lat, ln1_g[l], ln1_b[l])
        ff_lat = swiglu(h_lat * (1 + sc2) + sh2, ffn_w_gu[l], ffn_w_down[l])
        h_lat = layer_norm(DEEPNORM_ALPHA * h_lat + g2 * ff_lat, ln2_g[l], ln2_b[l])
    return h_lat
```

```cpp
#include <hip/hip_runtime.h>
#include <cstdio>
#include <cstdint>

#ifndef MK_PER_PHASE
#define MK_PER_PHASE 0
#define PROBE_DUP 0
#endif

#define LAS __attribute__((address_space(3)))
typedef unsigned short bf16_t;
typedef short bf16x8 __attribute__((ext_vector_type(8)));
typedef short s16x4 __attribute__((ext_vector_type(4)));
typedef float f32x4 __attribute__((ext_vector_type(4)));
typedef float f32x16 __attribute__((ext_vector_type(16)));
typedef float f32x2 __attribute__((ext_vector_type(2)));
typedef unsigned u32x4 __attribute__((ext_vector_type(4)));
typedef unsigned u32x2 __attribute__((ext_vector_type(2)));

constexpr int DM = 2048, NBATCH = 4, SEQ = 4096, CTXL = 256, DEPTH = 4;
constexpr int TPB = CTXL + SEQ;
constexpr int T = NBATCH * TPB;
constexpr int INW = 12352, ZW = 12544;
constexpr int ZS = 6208;
constexpr int NZQ = 0, NZKV = 512, NSU = 1024, NSV = 2048, NDQ = 3072, NDK = 4096, NDV = 5120, NG = 6144, NKR = 12288;
constexpr int FF = 5632;
constexpr int LDM = DM + 64;
constexpr float ALPHA = 1.681792830507429f;
constexpr float EPS = 1e-5f;
constexpr int NPH = 12;
enum { PH_CONV = 0, PH_INIT, PH_WIN, PH_UP, PH_ATTN, PH_DIFFC, PH_MERGE, PH_OUT, PH_LN1, PH_GU, PH_DOWN, PH_LN2 };

constexpr size_t WS_CTL = 0, CTL_BYTES = 1u << 20;
constexpr size_t WS_MOD = WS_CTL + CTL_BYTES;
constexpr size_t MOD_BYTES = (size_t)DEPTH * 5 * 6 * DM * 4;
constexpr size_t WS_MISC = WS_MOD + MOD_BYTES;
constexpr size_t MISC_BYTES = 65536;
constexpr size_t WS_WB = WS_MISC + MISC_BYTES;
constexpr size_t WE_IN = 0, WE_UQ = WE_IN + (size_t)ZW * DM, WE_UKV = WE_UQ + (size_t)1536 * 512, WE_BR = WE_UKV + (size_t)2048 * 512,
                 WE_OUT = WE_BR + (size_t)3 * DM * 1024, WE_GU = WE_OUT + (size_t)DM * DM, WE_DN = WE_GU + (size_t)2 * FF * DM, WE_END = WE_DN + (size_t)DM * FF;
constexpr size_t WS_H = WS_WB + WE_END * 2;
constexpr size_t WS_XM = WS_H + (size_t)T * DM * 4;
constexpr size_t WS_Z = WS_XM + (size_t)T * DM * 2;
constexpr size_t WS_GN = WS_Z + (size_t)T * ZS * 2;
constexpr size_t WS_B = WS_GN + (size_t)(T / 256) * 24 * 131072;
constexpr size_t B_QM = 0, B_KM = B_QM + (size_t)T * 1536 * 2, B_VM = B_KM + (size_t)T * 1536 * 2, B_Y3 = B_VM + (size_t)T * 1024 * 2,
                 B_OD = B_Y3 + (size_t)3 * T * 1024 * 2, B_SSQ = B_OD + (size_t)2 * T * 1024 * 4, B_SVS = B_SSQ + (size_t)T * 16 * 4, B_END = B_SVS + (size_t)T * 16 * 8;
constexpr size_t WS_MRG = WS_B + B_END;
constexpr size_t WS_MIX = WS_MRG + (size_t)T * LDM * 2;
constexpr size_t WS_PART = WS_MIX + (size_t)T * LDM * 2;
constexpr size_t WS_END = WS_PART + (size_t)8 * 1024 * LDM * 2;
static_assert((size_t)T * FF * 2 <= B_END, "overlays");
static_assert(WS_END <= 1619001344ull, "workspace budget (4 x largest tensor)");
static_assert(WS_WB % 256 == 0 && WS_H % 256 == 0 && WS_Z % 256 == 0 && WS_B % 256 == 0 && B_OD % 256 == 0 && B_SSQ % 256 == 0 && B_SVS % 256 == 0, "alignment");

constexpr int LDS_RING = 131072, LDS_BYTES = 147456, LDS_MISC = LDS_BYTES - 256;

__device__ __forceinline__ float bf2f(unsigned short b) { return __uint_as_float(((unsigned)b) << 16); }
__device__ __forceinline__ unsigned f2bf(float f) { unsigned u = __float_as_uint(f); return (u + 0x7fffu + ((u >> 16) & 1u)) >> 16; }
typedef __bf16 bf16x2_g __attribute__((ext_vector_type(2)));
typedef float f32x2_g __attribute__((ext_vector_type(2)));
__device__ __forceinline__ unsigned pk2(float lo, float hi) { const f32x2_g v = {lo, hi}; return __builtin_bit_cast(unsigned, __builtin_convertvector(v, bf16x2_g)); }
__device__ __forceinline__ void unpack8(u32x4 w, float (&f)[8]) {
    f[0] = __uint_as_float(w.x << 16); f[1] = __uint_as_float(w.x & 0xffff0000u); f[2] = __uint_as_float(w.y << 16); f[3] = __uint_as_float(w.y & 0xffff0000u);
    f[4] = __uint_as_float(w.z << 16); f[5] = __uint_as_float(w.z & 0xffff0000u); f[6] = __uint_as_float(w.w << 16); f[7] = __uint_as_float(w.w & 0xffff0000u);
}
__device__ __forceinline__ u32x4 pack8(const float (&f)[8]) { u32x4 w; w.x = pk2(f[0], f[1]); w.y = pk2(f[2], f[3]); w.z = pk2(f[4], f[5]); w.w = pk2(f[6], f[7]); return w; }
__device__ __forceinline__ float shflx(float v, int mask, int lane) { return __int_as_float(__builtin_amdgcn_ds_bpermute((lane ^ mask) << 2, __float_as_int(v))); }
__device__ __forceinline__ float wave_sum(float v, int lane) {
#pragma unroll
    for (int o = 1; o < 64; o <<= 1) v += shflx(v, o, lane);
    return v;
}
__device__ __forceinline__ float sigmoidf_(float x) { return __builtin_amdgcn_rcpf(1.0f + __builtin_amdgcn_exp2f(-1.4426950408889634f * x)); }
__device__ __forceinline__ float gelu_tanh(float x) { const float u = 0.7978845608028654f * (x + 0.044715f * x * x * x); const float t = 1.0f - 2.0f * __builtin_amdgcn_rcpf(1.0f + __builtin_amdgcn_exp2f(2.8853900817779268f * u)); return 0.5f * x * (1.0f + t); }

__device__ __forceinline__ int fresh_zero() { int z = 0; asm volatile("" : "+s"(z)); return z; }
__device__ __forceinline__ unsigned char* fresh_ptr(unsigned char* p) {
    unsigned lo = __builtin_amdgcn_readfirstlane((unsigned)(uintptr_t)p), hi = __builtin_amdgcn_readfirstlane((unsigned)((uintptr_t)p >> 32));
    asm volatile("" : "+s"(lo), "+s"(hi));
    return (unsigned char*)(((uintptr_t)hi << 32) | (uintptr_t)lo);
}
__device__ __forceinline__ int fresh_tid() { int t = threadIdx.x; asm volatile("" : "+v"(t)); return t; }

#define XB_TMO      128
#define XB_XCNT(j)  (256  + 64 * (j))
#define XB_XSUB(j)  (1280 + 64 * (j))
#define XB_XGEN(j)  (2304 + 64 * (j))
#define XB_TOP      3328
#define XB_TOPGEN   3392
#define XCD_BAR_WORDS 3456
#define XB_SPIN_CAP (1u << 18)
__device__ __forceinline__ unsigned xb_ld(unsigned* p)              { return __hip_atomic_load(p, __ATOMIC_RELAXED, __HIP_MEMORY_SCOPE_AGENT); }
__device__ __forceinline__ unsigned xb_add(unsigned* p, unsigned v) { return __hip_atomic_fetch_add(p, v, __ATOMIC_RELAXED, __HIP_MEMORY_SCOPE_AGENT); }
__device__ __forceinline__ unsigned xb_xcc_id() { return (unsigned)__builtin_amdgcn_s_getreg((3 << 11) | 20) & 0xFu; }
#define XB_SPIN(cond, bar) do { unsigned _sp = 0; while (cond) { __builtin_amdgcn_s_sleep(1); \
    if ((++_sp & 255u) == 0u) { if (xb_ld(&(bar)[XB_TMO])) break; if (_sp > XB_SPIN_CAP) { atomicAdd(&(bar)[XB_TMO], 1u); break; } } } } while (0)
struct XcdBarrier { unsigned* bar; unsigned x; volatile LAS unsigned* st; };
__device__ __forceinline__ XcdBarrier xcd_barrier_post(unsigned* bar, volatile LAS unsigned* st) {
    XcdBarrier b; b.bar = bar; b.x = xb_xcc_id(); b.st = st;
    if (threadIdx.x == 0) (void)xb_add(&bar[XB_XCNT(b.x)], 1u);
    return b;
}
__device__ __forceinline__ void xcd_barrier_complete(unsigned* bar, unsigned x, unsigned& nloc, unsigned& nx) {
    const unsigned G = gridDim.x * gridDim.y * gridDim.z;
    unsigned sum, cnt, mine, sp = 0u;
    for (;;) {
        sum = 0u; cnt = 0u; mine = 0u;
#pragma unroll
        for (unsigned j = 0; j < 16; ++j) { const unsigned c = xb_ld(&bar[XB_XCNT(j)]); sum += c; cnt += (c > 0u) ? 1u : 0u; mine = (j == x) ? c : mine; }
        if (sum == G) break;
        __builtin_amdgcn_s_sleep(1);
        if ((++sp & 255u) == 0u) { if (xb_ld(&bar[XB_TMO])) break; if (sp > XB_SPIN_CAP) { atomicAdd(&bar[XB_TMO], 1u); break; } }
    }
    nloc = mine > 0u ? mine : 1u; nx = cnt > 0u ? cnt : 1u;
}
__device__ __forceinline__ void xcd_barrier(const XcdBarrier& b) {
    asm volatile("s_waitcnt vmcnt(0)" ::: "memory");
    __syncthreads();
    if (threadIdx.x == 0) {
        unsigned* bar = b.bar;
        __builtin_amdgcn_s_waitcnt(0);
        unsigned nloc = b.st[0], nx = b.st[1];
        if (nloc == 0u) { xcd_barrier_complete(bar, b.x, nloc, nx); b.st[0] = nloc; b.st[1] = nx; }
        const unsigned old = xb_add(&bar[XB_XSUB(b.x)], 1u);
        const unsigned gen = old / nloc;
        if (old + 1u == (gen + 1u) * nloc) {
            __builtin_amdgcn_fence(__ATOMIC_RELEASE, "agent");
            asm volatile("s_waitcnt vmcnt(0)" ::: "memory");
            const unsigned og = xb_add(&bar[XB_TOP], 1u);
            const unsigned tg = og / nx;
            if (og + 1u == (tg + 1u) * nx) xb_add(&bar[XB_TOPGEN], 1u);
            else XB_SPIN(xb_ld(&bar[XB_TOPGEN]) == tg, bar);
            __builtin_amdgcn_fence(__ATOMIC_ACQUIRE, "agent");
            xb_add(&bar[XB_XGEN(b.x)], 1u);
            asm volatile("s_waitcnt vmcnt(0)" ::: "memory");
        } else {
            XB_SPIN(xb_ld(&bar[XB_XGEN(b.x)]) == gen, bar);
            __builtin_amdgcn_fence(__ATOMIC_ACQUIRE, "agent");
            asm volatile("s_waitcnt vmcnt(0)" ::: "memory");
        }
    }
    __syncthreads();
}

namespace pg8 {
constexpr int BM = 256, BK = 64, HALF = 128, HTB = HALF * BK * 2, STAGE_BYTES = 8 * HTB, NXCD = 8, WGM = 4;
__host__ __device__ __forceinline__ int lds_byte(int r, int c) { const int st = (r >> 4) * 2 + (c >> 5), rr = r & 15, cc = c & 31, ob = rr * 64 + cc * 2; return st * 1024 + (ob ^ (((ob >> 9) & 1) << 5)); }
__host__ __device__ __forceinline__ void stage_rc(int b, int& R, int& C) { const int st = b / 1024, sb = b % 1024, swz = sb ^ (((sb >> 9) & 1) << 5); R = (st >> 1) * 16 + swz / 64; C = (st & 1) * 32 + (swz % 64) / 2; }
__host__ __device__ __forceinline__ int perm32(int rho) { const int n = rho >> 4, i = rho & 15; return 8 * (i >> 2) + 4 * n + (i & 3); }

struct Unit { int pm, pn, seg, nt; };
struct Gemm { const bf16_t* A; const bf16_t* Bt; int M, N, K, lda, ldb; size_t segA, segB; };

struct StaticOrder {
    int tailS = 0, tailnt = 0;
    int tailM = 0;
    int wgm = WGM;
    int nM, nN, nwg, G, c, nseg, dup, latonly, pnsplit = 0;
    __device__ void init(int M, int N, int G_, int c_, int nseg_ = 1, int dup_ = 1, int latonly_ = 0, int drop_ = 0) { nM = latonly_ ? 64 : M / BM; nN = N / BM; nwg = nM * nN - drop_; G = G_; c = c_; nseg = nseg_; dup = dup_; latonly = latonly_; }
    __device__ bool next(int i, Unit& u) const {
        const int per = nseg * dup, ti = i / per; u.seg = (i - ti * per) % nseg; u.nt = 0;
        if (tailM) { const int i0 = per * (512 / G); if (i >= i0) { const int idx = c + G * (i - i0); if (idx >= 96) return false; const int tile = idx / 3; u.pm = 64 + (tile >> 3); u.pn = tile & 7; u.seg = idx - tile * 3; u.nt = 16; return true; } }
        if (tailS) { const long Lt = (long)ti * G + c;
            if (Lt >= 512) { const int idx = (int)(Lt - 512); if (idx >= 32 * tailS) return false; const int tile = idx / tailS; u.pm = 64 + (tile >> 3); u.pn = tile & 7; u.seg = idx - tile * tailS; u.nt = tailnt; return true; } }
        const long L = (long)ti * G + c; if (L >= nwg) return false;
        int wgid = (int)L; { const int q = nwg / NXCD, r = nwg % NXCD, xcd = wgid % NXCD, off = wgid / NXCD; wgid = (xcd < r ? xcd * (q + 1) : r * (q + 1) + (xcd - r) * q) + off; }
        const int nig = wgm * nN, gid = wgid / nig, fm = gid * wgm, gsz = (nM - fm) < wgm ? (nM - fm) : wgm;
        u.pm = fm + ((wgid % nig) % gsz); u.pn = (wgid % nig) / gsz; if (latonly) u.pm = (u.pm >> 4) * 17 + 1 + (u.pm & 15); if (pnsplit) u.seg = u.pn >= pnsplit; return true;
    }
    __device__ __forceinline__ void a_ready(const Unit&) const {}
    __device__ __forceinline__ void done(const Unit&) const {}
};

typedef __bf16 bf16x2_t __attribute__((ext_vector_type(2)));
typedef float f32x2_t __attribute__((ext_vector_type(2)));
__device__ __forceinline__ unsigned cvt_pk_bf16(float lo, float hi) { const f32x2_t v = {lo, hi}; return __builtin_bit_cast(unsigned, __builtin_convertvector(v, bf16x2_t)); }

struct EpiBf16 {
    __device__ __forceinline__ void prefetch(const Unit&, LAS unsigned char*, int) const {}
    static constexpr int ID = 1; static constexpr bool IDEMP = true; static constexpr bool PERM = true;
    bf16_t* O; int ldc; bf16_t* P = nullptr;
    __device__ __forceinline__ bool keep(const Unit&) const { return false; }
    __device__ __forceinline__ void operator()(f32x4 (&acc)[2][2][4][2], const Unit& u, int wr, int wc, int fr, int fq) const {
        const int row0 = u.pm * BM + wr * 64 + fr, col0 = u.pn * BM + wc * 32 + 8 * fq;
        bf16_t* ob = u.nt ? P + ((size_t)u.seg * 1024 - 16384) * ldc : O;
#pragma unroll
        for (int ai = 0; ai < 2; ++ai)
#pragma unroll
            for (int m = 0; m < 4; ++m) { bf16_t* rowp = ob + (size_t)(row0 + ai * HALF + m * 16) * ldc + col0;
#pragma unroll
                for (int bj = 0; bj < 2; ++bj) { const f32x4 v0 = acc[ai][bj][m][0], v1 = acc[ai][bj][m][1];
                    u32x4 w; w.x = cvt_pk_bf16(v0[0], v0[1]); w.y = cvt_pk_bf16(v0[2], v0[3]); w.z = cvt_pk_bf16(v1[0], v1[1]); w.w = cvt_pk_bf16(v1[2], v1[3]);
                    *(u32x4*)(rowp + bj * HALF) = w; } }
    }
};
struct EpiWin {
    __device__ __forceinline__ void prefetch(const Unit&, LAS unsigned char*, int) const {}
    static constexpr int ID = 2; static constexpr bool IDEMP = true; static constexpr bool PERM = true;
    bf16_t* Z; bf16_t* GN; bf16_t* KM; float* SSQ; float2* SVS; const float2* T128; const float2* T64;
    __device__ __forceinline__ bool keep(const Unit&) const { return false; }
    __device__ __forceinline__ void st8(bf16_t* p, const float (&v)[8]) const { u32x4 w; w.x = cvt_pk_bf16(v[0], v[1]); w.y = cvt_pk_bf16(v[2], v[3]); w.z = cvt_pk_bf16(v[4], v[5]); w.w = cvt_pk_bf16(v[6], v[7]); *(u32x4*)p = w; }
    __device__ __forceinline__ void operator()(f32x4 (&acc)[2][2][4][2], const Unit& u, int wr, int wc, int fr, int fq) const {
        const int pn = u.pn, lane = fq * 16 + fr, pmb = u.pm % 17; const bool lat = pmb != 0;
        const int row0 = u.pm * BM + wr * 64 + fr, colq = wc * 32 + 8 * fq;
        bf16_t* zp = Z + (size_t)row0 * ZS + pn * BM + colq;
#define EW_ROWS for (int ai = 0; ai < 2; ++ai) _Pragma("unroll") for (int m = 0; m < 4; ++m)
#define EW_V(bj, e) acc[ai][bj][m][(e) >> 2][(e) & 3]
#define EW_ZP(bj) (zp + (size_t)(ai * HALF + m * 16) * ZS + (bj) * HALF)
        if (pn < 4) {
#pragma unroll
            EW_ROWS { float ss = 0.f;
#pragma unroll
                for (int bj = 0; bj < 2; ++bj) { float v[8];
#pragma unroll
                    for (int e = 0; e < 8; ++e) { v[e] = EW_V(bj, e); ss += v[e] * v[e]; }
                    st8(EW_ZP(bj), v); }
                ss += shflx(ss, 16, lane); ss += shflx(ss, 32, lane);
                if (fq == 0) SSQ[(size_t)(row0 + ai * HALF + m * 16) * 16 + pn * 4 + wc] = ss; }
        } else if (pn < 8) {
#pragma unroll
            EW_ROWS {
#pragma unroll
                for (int bj = 0; bj < 2; ++bj) { float v[8];
#pragma unroll
                    for (int e = 0; e < 8; ++e) v[e] = gelu_tanh(EW_V(bj, e));
                    st8(EW_ZP(bj), v); } }
        } else if (pn < 12) {
#pragma unroll
            EW_ROWS { float s = 0.f, ss = 0.f;
#pragma unroll
                for (int bj = 0; bj < 2; ++bj) { float v[8];
#pragma unroll
                    for (int e = 0; e < 8; ++e) { const float g = gelu_tanh(EW_V(bj, e)); v[e] = g; s += g; ss += g * g; }
                    st8(EW_ZP(bj), v); }
                s += shflx(s, 16, lane); s += shflx(s, 32, lane); ss += shflx(ss, 16, lane); ss += shflx(ss, 32, lane);
                if (fq == 0) SVS[(size_t)(row0 + ai * HALF + m * 16) * 16 + (pn - 8) * 4 + wc] = make_float2(s, ss); }
        } else if (pn < 20 && lat) {
#pragma unroll
            for (int ai = 0; ai < 2; ++ai) { f32x4 c01[4], c23[4];
#pragma unroll
                for (int m = 0; m < 4; ++m) { const int prow = (pmb - 1) * 4 + 2 * ai + wr, pcol = 16 * m + fr;
                    const float2* tp = T128 + ((wc >> 1) ? pcol : prow) * 32 + 16 * (wc & 1) + 4 * fq; c01[m] = *(const f32x4*)tp; c23[m] = *(const f32x4*)(tp + 2); }
                __builtin_amdgcn_sched_barrier(0);
#pragma unroll
                for (int m = 0; m < 4; ++m) {
                    const float cs[4] = {c01[m][0], c01[m][2], c23[m][0], c23[m][2]}, sn[4] = {c01[m][1], c01[m][3], c23[m][1], c23[m][3]};
#pragma unroll
                    for (int bj = 0; bj < 2; ++bj) { float v[8];
#pragma unroll
                        for (int p = 0; p < 4; ++p) { const float x1 = EW_V(bj, 2 * p), x2 = EW_V(bj, 2 * p + 1); v[2 * p] = x1 * cs[p] - x2 * sn[p]; v[2 * p + 1] = x2 * cs[p] + x1 * sn[p]; }
                        st8(EW_ZP(bj), v); } } }
        } else if (pn < 24) {
#pragma unroll
            EW_ROWS {
#pragma unroll
                for (int bj = 0; bj < 2; ++bj) { float v[8];
#pragma unroll
                    for (int e = 0; e < 8; ++e) v[e] = EW_V(bj, e);
                    st8(EW_ZP(bj), v); } }
        } else if (pn < 48) {
            bf16_t* gt = GN + ((size_t)u.pm * 24 + (pn - 24)) * 65536 + ((size_t)(wr * 4 + wc) * 16 * 64 + lane) * 8;
#pragma unroll
            EW_ROWS {
#pragma unroll
                for (int bj = 0; bj < 2; ++bj) { float v[8];
#pragma unroll
                    for (int e = 0; e < 8; ++e) v[e] = sigmoidf_(EW_V(bj, e));
                    st8(gt + ((ai * 4 + m) * 2 + bj) * 512, v); } }
        } else if (wc < 2) {
#pragma unroll
            EW_ROWS { const int prow = (pmb - 1) * 4 + 2 * ai + wr, pcol = 16 * m + fr; float v[8];
#pragma unroll
                for (int e = 0; e < 8; ++e) v[e] = EW_V(0, e);
                if (lat) { const float2* tp = T64 + (wc ? pcol : prow) * 16 + 4 * fq; const f32x4 c01 = *(const f32x4*)tp, c23 = *(const f32x4*)(tp + 2);
                    const float cs[4] = {c01[0], c01[2], c23[0], c23[2]}, sn[4] = {c01[1], c01[3], c23[1], c23[3]};
#pragma unroll
                    for (int p = 0; p < 4; ++p) { const float x1 = v[2 * p], x2 = v[2 * p + 1]; v[2 * p] = x1 * cs[p] - x2 * sn[p]; v[2 * p + 1] = x2 * cs[p] + x1 * sn[p]; } }
                u32x4 w; w.x = cvt_pk_bf16(v[0], v[1]); w.y = cvt_pk_bf16(v[2], v[3]); w.z = cvt_pk_bf16(v[4], v[5]); w.w = cvt_pk_bf16(v[6], v[7]);
#pragma unroll
                for (int h = 0; h < 8; ++h) *(u32x4*)(KM + (size_t)(row0 + ai * HALF + m * 16) * 1536 + h * 192 + 128 + colq) = w; }
        }
#undef EW_ROWS
#undef EW_V
#undef EW_ZP
    }
};
struct EpiUQ {
    __device__ __forceinline__ void prefetch(const Unit&, LAS unsigned char*, int) const {}
    static constexpr int ID = 3; static constexpr bool IDEMP = true; static constexpr bool PERM = true;
    bf16_t* QM; const float* SSQ; const float2* T64;
    __device__ __forceinline__ bool keep(const Unit&) const { return false; }
    __device__ __forceinline__ void operator()(f32x4 (&acc)[2][2][4][2], const Unit& u, int wr, int wc, int fr, int fq) const {
        const int pmb = u.pm % 17; const bool lat = pmb != 0;
        const int row0 = u.pm * BM + wr * 64 + fr;
#pragma unroll
        for (int ai = 0; ai < 2; ++ai) {
            f32x4 s0[4], s1[4]; float rstd[4];
#pragma unroll
            for (int m = 0; m < 4; ++m) { const float* sp = SSQ + (size_t)(row0 + ai * HALF + m * 16) * 16; s0[m] = *(const f32x4*)sp; s1[m] = *(const f32x4*)(sp + 4); }
#pragma unroll
            for (int m = 0; m < 4; ++m) rstd[m] = rsqrtf(((s0[m][0] + s0[m][1]) + (s0[m][2] + s0[m][3]) + (s1[m][0] + s1[m][1]) + (s1[m][2] + s1[m][3])) * (1.0f / 512.0f) + EPS);
#pragma unroll
            for (int bj = 0; bj < 2; ++bj) {
                const int c0 = u.pn * BM + bj * HALF + wc * 32 + 8 * fq, h = c0 / 192, d0 = c0 - h * 192;
                const int cg = u.pn * BM + bj * HALF + wc * 32, dg = cg - (cg / 192) * 192;
                if (lat && dg >= 128) {
                    const int r0 = d0 - 128;
                    f32x4 c01s[4], c23s[4];
#pragma unroll
                    for (int m = 0; m < 4; ++m) { const int prow = (pmb - 1) * 4 + 2 * ai + wr, pcol = 16 * m + fr;
                        const float2* tp = T64 + ((r0 >> 5) ? pcol : prow) * 16 + ((r0 >> 1) & 15); c01s[m] = *(const f32x4*)tp; c23s[m] = *(const f32x4*)(tp + 2); }
                    __builtin_amdgcn_sched_barrier(0);
#pragma unroll
                    for (int m = 0; m < 4; ++m) { const f32x4 c01 = c01s[m], c23 = c23s[m];
                        const float cs[4] = {c01[0], c01[2], c23[0], c23[2]}, sn[4] = {c01[1], c01[3], c23[1], c23[3]}; float v[8];
#pragma unroll
                        for (int p = 0; p < 4; ++p) { const float x1 = acc[ai][bj][m][p >> 1][(2 * p) & 3] * rstd[m], x2 = acc[ai][bj][m][p >> 1][(2 * p + 1) & 3] * rstd[m]; v[2 * p] = x1 * cs[p] - x2 * sn[p]; v[2 * p + 1] = x2 * cs[p] + x1 * sn[p]; }
                        u32x4 w; w.x = cvt_pk_bf16(v[0], v[1]); w.y = cvt_pk_bf16(v[2], v[3]); w.z = cvt_pk_bf16(v[4], v[5]); w.w = cvt_pk_bf16(v[6], v[7]);
                        *(u32x4*)(QM + (size_t)(row0 + ai * HALF + m * 16) * 1536 + c0) = w; }
                } else {
#pragma unroll
                    for (int m = 0; m < 4; ++m) { const f32x4 v0 = acc[ai][bj][m][0] * rstd[m], v1 = acc[ai][bj][m][1] * rstd[m];
                        u32x4 w; w.x = cvt_pk_bf16(v0[0], v0[1]); w.y = cvt_pk_bf16(v0[2], v0[3]); w.z = cvt_pk_bf16(v1[0], v1[1]); w.w = cvt_pk_bf16(v1[2], v1[3]);
                        *(u32x4*)(QM + (size_t)(row0 + ai * HALF + m * 16) * 1536 + c0) = w; }
                }
            }
        }
    }
};
struct EpiUKV {
    __device__ __forceinline__ void prefetch(const Unit&, LAS unsigned char*, int) const {}
    static constexpr int ID = 4; static constexpr bool IDEMP = true; static constexpr bool PERM = true;
    bf16_t* KM; bf16_t* VM; const float* SSQ;
    __device__ __forceinline__ bool keep(const Unit&) const { return false; }
    __device__ __forceinline__ void operator()(f32x4 (&acc)[2][2][4][2], const Unit& u, int wr, int wc, int fr, int fq) const {
        const int row0 = u.pm * BM + wr * 64 + fr;
#pragma unroll
        for (int ai = 0; ai < 2; ++ai) {
            f32x4 s0[4], s1[4]; float rstd[4];
#pragma unroll
            for (int m = 0; m < 4; ++m) { const float* sp = SSQ + (size_t)(row0 + ai * HALF + m * 16) * 16 + 8; s0[m] = *(const f32x4*)sp; s1[m] = *(const f32x4*)(sp + 4); }
#pragma unroll
            for (int m = 0; m < 4; ++m) rstd[m] = rsqrtf(((s0[m][0] + s0[m][1]) + (s0[m][2] + s0[m][3]) + (s1[m][0] + s1[m][1]) + (s1[m][2] + s1[m][3])) * (1.0f / 512.0f) + EPS);
            if (u.pn < 4) {
#pragma unroll
                for (int m = 0; m < 4; ++m)
#pragma unroll
                    for (int bj = 0; bj < 2; ++bj) { const int c0 = u.pn * BM + bj * HALF + wc * 32 + 8 * fq; const f32x4 v0 = acc[ai][bj][m][0] * rstd[m], v1 = acc[ai][bj][m][1] * rstd[m];
                        u32x4 w; w.x = cvt_pk_bf16(v0[0], v0[1]); w.y = cvt_pk_bf16(v0[2], v0[3]); w.z = cvt_pk_bf16(v1[0], v1[1]); w.w = cvt_pk_bf16(v1[2], v1[3]);
                        *(u32x4*)(KM + (size_t)(row0 + ai * HALF + m * 16) * 1536 + (c0 >> 7) * 192 + (c0 & 127)) = w; }
            } else {
#pragma unroll
                for (int m = 0; m < 4; ++m)
#pragma unroll
                    for (int bj = 0; bj < 2; ++bj) { const int c0 = u.pn * BM + bj * HALF + wc * 32 + 8 * fq; const f32x4 v0 = acc[ai][bj][m][0] * rstd[m], v1 = acc[ai][bj][m][1] * rstd[m];
                        u32x4 w; w.x = cvt_pk_bf16(v0[0], v0[1]); w.y = cvt_pk_bf16(v0[2], v0[3]); w.z = cvt_pk_bf16(v1[0], v1[1]); w.w = cvt_pk_bf16(v1[2], v1[3]);
                        *(u32x4*)(VM + (size_t)(row0 + ai * HALF + m * 16) * 1024 + (c0 - 1024)) = w; }
            }
        }
    }
};
struct EpiUQKV {
    __device__ __forceinline__ void prefetch(const Unit&, LAS unsigned char*, int) const {}
    static constexpr int ID = 7; static constexpr bool IDEMP = true; static constexpr bool PERM = true;
    EpiUQ q; EpiUKV kv;
    __device__ __forceinline__ bool keep(const Unit&) const { return false; }
    __device__ __forceinline__ void operator()(f32x4 (&acc)[2][2][4][2], const Unit& u, int wr, int wc, int fr, int fq) const {
        if (u.pn < 6) q(acc, u, wr, wc, fr, fq);
        else { Unit v = u; v.pn = u.pn - 6; kv(acc, v, wr, wc, fr, fq); }
    }
};
struct EpiSwiGlu {
    __device__ __forceinline__ void prefetch(const Unit&, LAS unsigned char*, int) const {}
    static constexpr int ID = 5; static constexpr bool IDEMP = true; static constexpr bool PERM = true;
    bf16_t* O;
    __device__ __forceinline__ bool keep(const Unit&) const { return false; }
    __device__ __forceinline__ void operator()(f32x4 (&acc)[2][2][4][2], const Unit& u, int wr, int wc, int fr, int fq) const {
        const int row0 = u.pm * BM + wr * 64 + fr, col0 = u.pn * HALF + wc * 32 + 8 * fq;
#pragma unroll
        for (int ai = 0; ai < 2; ++ai)
#pragma unroll
            for (int m = 0; m < 4; ++m) { bf16_t* rowp = O + (size_t)(row0 + ai * HALF + m * 16) * FF + col0;
                float h[8];
#pragma unroll
                for (int n = 0; n < 2; ++n)
#pragma unroll
                    for (int e = 0; e < 4; ++e) { const float g = acc[ai][0][m][n][e], up = acc[ai][1][m][n][e]; h[n * 4 + e] = g * __builtin_amdgcn_rcpf(1.0f + __builtin_amdgcn_exp2f(-1.4426950408889634f * g)) * up; }
                u32x4 w; w.x = cvt_pk_bf16(h[0], h[1]); w.y = cvt_pk_bf16(h[2], h[3]); w.z = cvt_pk_bf16(h[4], h[5]); w.w = cvt_pk_bf16(h[6], h[7]);
                *(u32x4*)rowp = w; }
    }
};
struct EpiMerge {
    __device__ __forceinline__ void prefetch(const Unit& u, LAS unsigned char* lds, int tid) const {
        const int wid = __builtin_amdgcn_readfirstlane(tid >> 6);
        const bf16_t* gp = G + ((size_t)u.pm * 24 + (u.seg < 2 ? u.seg : 2) * 8 + u.pn) * 65536 + (size_t)tid * 128;
        LAS unsigned* dst = (LAS unsigned*)(lds + STAGE_BYTES + 1024 + wid * 256);
        __builtin_amdgcn_global_load_lds((const unsigned*)gp, dst, 4, 0, 0);
        __builtin_amdgcn_global_load_lds((const unsigned*)(gp + 64), dst, 4, 0, 0);
        if (u.seg < 2) { __builtin_amdgcn_global_load_lds((const unsigned*)(gp + 8 * 65536), dst, 4, 0, 0); __builtin_amdgcn_global_load_lds((const unsigned*)(gp + 8 * 65536 + 64), dst, 4, 0, 0); }
    }
    static constexpr int ID = 6; static constexpr bool IDEMP = false; static constexpr bool PERM = true;
    const bf16_t* G;
    bf16_t* O;
    bf16_t* PM = nullptr; unsigned* cnt = nullptr;
    __device__ __forceinline__ bool keep(const Unit& u) const { return u.seg < 2 && u.nt == 0; }
    __device__ __forceinline__ void operator()(f32x4 (&acc)[2][2][4][2], const Unit& u, int wr, int wc, int fr, int fq) const {
        const int row0 = u.pm * BM + wr * 64 + fr, col0 = u.pn * BM + wc * 32 + 8 * fq;
        const bf16_t* gl = G + ((size_t)u.pm * 24 + u.pn) * 65536 + ((size_t)(wr * 4 + wc) * 16 * 64 + fq * 16 + fr) * 8;
        if (u.nt) {
            const int tile = (u.pm - 64) * 8 + u.pn, w = wr * 4 + wc;
            const auto rsrc = __builtin_amdgcn_make_buffer_rsrc((void*)PM, 0, 96 * 131072, 0x00020000);
            const unsigned pbase = (unsigned)(tile * 3) * 131072u + (unsigned)((w * 16 * 64 + fq * 16 + fr) * 16);
#pragma unroll
            for (int ai = 0; ai < 2; ++ai) {
                u32x4 ra[4][2];
#pragma unroll
                for (int m = 0; m < 4; ++m)
#pragma unroll
                    for (int bj = 0; bj < 2; ++bj) ra[m][bj] = *(const u32x4*)(gl + (size_t)u.seg * 8 * 65536 + ((ai * 4 + m) * 2 + bj) * 512);
#pragma unroll
                for (int m = 0; m < 4; ++m)
#pragma unroll
                    for (int bj = 0; bj < 2; ++bj) { float f[8]; unpack8(ra[m][bj], f);
                        const f32x4 v0 = acc[ai][bj][m][0], v1 = acc[ai][bj][m][1];
                        u32x4 wv; wv.x = cvt_pk_bf16(v0[0] * f[0], v0[1] * f[1]); wv.y = cvt_pk_bf16(v0[2] * f[2], v0[3] * f[3]); wv.z = cvt_pk_bf16(v1[0] * f[4], v1[1] * f[5]); wv.w = cvt_pk_bf16(v1[2] * f[6], v1[3] * f[7]);
                        __builtin_amdgcn_raw_buffer_store_b128(wv, rsrc, pbase + (unsigned)u.seg * 131072u + (unsigned)(((ai * 4 + m) * 2 + bj) * 1024), 0,   16); }
            }
            asm volatile("s_waitcnt vmcnt(0)" ::: "memory");
            unsigned old = 0; if ((fq | fr) == 0) old = __hip_atomic_fetch_add(cnt + tile * 8 + w, 1u, __ATOMIC_RELAXED, __HIP_MEMORY_SCOPE_AGENT);
            old = (unsigned)__builtin_amdgcn_readfirstlane((int)old);
            if (old == 2) {
                __builtin_amdgcn_fence(__ATOMIC_ACQUIRE, "agent"); asm volatile("s_waitcnt vmcnt(0)" ::: "memory");
                const bf16_t* pp = PM + (size_t)tile * 3 * 65536 + ((size_t)w * 16 * 64 + fq * 16 + fr) * 8;
#pragma unroll
                for (int am = 0; am < 4; ++am) { const int ai = am >> 1, mb = (am & 1) * 2;
                    u32x4 rp[2][2][3];
#pragma unroll
                    for (int mm = 0; mm < 2; ++mm)
#pragma unroll
                        for (int bj = 0; bj < 2; ++bj)
#pragma unroll
                            for (int s = 0; s < 3; ++s) rp[mm][bj][s] = *(const u32x4*)(pp + (size_t)s * 65536 + ((ai * 4 + mb + mm) * 2 + bj) * 512);
#pragma unroll
                    for (int mm = 0; mm < 2; ++mm)
#pragma unroll
                        for (int bj = 0; bj < 2; ++bj) { float a[8], b[8], c3[8]; unpack8(rp[mm][bj][0], a); unpack8(rp[mm][bj][1], b); unpack8(rp[mm][bj][2], c3);
#pragma unroll
                            for (int e = 0; e < 8; ++e) a[e] = (a[e] + b[e]) + c3[e];
                            *(u32x4*)(O + (size_t)(row0 + ai * HALF + (mb + mm) * 16) * LDM + col0 + bj * HALF) = pack8(a); }
                }
            }
        } else if (u.seg < 2) {
            const bf16_t* gbase = gl + (size_t)u.seg * 8 * 65536;
#pragma unroll
            for (int am = 0; am < 4; ++am) { const int ai = am >> 1, mb = (am & 1) * 2;
                u32x4 ra[2][2], rb[2][2];
#pragma unroll
                for (int mm = 0; mm < 2; ++mm)
#pragma unroll
                    for (int bj = 0; bj < 2; ++bj) { const bf16_t* gp = gbase + ((ai * 4 + mb + mm) * 2 + bj) * 512; ra[mm][bj] = *(const u32x4*)gp; rb[mm][bj] = *(const u32x4*)(gp + 8 * 65536); }
#pragma unroll
                for (int mm = 0; mm < 2; ++mm)
#pragma unroll
                    for (int bj = 0; bj < 2; ++bj) { const int m = mb + mm; float ga[8], gb[8]; unpack8(ra[mm][bj], ga); unpack8(rb[mm][bj], gb);
                        f32x4 v0 = acc[ai][bj][m][0], v1 = acc[ai][bj][m][1];
                        v0[0] *= ga[0] * __builtin_amdgcn_rcpf(gb[0]); v0[1] *= ga[1] * __builtin_amdgcn_rcpf(gb[1]); v0[2] *= ga[2] * __builtin_amdgcn_rcpf(gb[2]); v0[3] *= ga[3] * __builtin_amdgcn_rcpf(gb[3]);
                        v1[0] *= ga[4] * __builtin_amdgcn_rcpf(gb[4]); v1[1] *= ga[5] * __builtin_amdgcn_rcpf(gb[5]); v1[2] *= ga[6] * __builtin_amdgcn_rcpf(gb[6]); v1[3] *= ga[7] * __builtin_amdgcn_rcpf(gb[7]);
                        acc[ai][bj][m][0] = v0; acc[ai][bj][m][1] = v1; }
            }
        } else {
#pragma unroll
            for (int ai = 0; ai < 2; ++ai) {
                u32x4 ra[4][2];
#pragma unroll
                for (int m = 0; m < 4; ++m)
#pragma unroll
                    for (int bj = 0; bj < 2; ++bj) ra[m][bj] = *(const u32x4*)(gl + (size_t)2 * 8 * 65536 + ((ai * 4 + m) * 2 + bj) * 512);
#pragma unroll
                for (int m = 0; m < 4; ++m)
#pragma unroll
                    for (int bj = 0; bj < 2; ++bj) { float f[8]; unpack8(ra[m][bj], f);
                        const f32x4 v0 = acc[ai][bj][m][0], v1 = acc[ai][bj][m][1];
                        u32x4 w; w.x = cvt_pk_bf16(v0[0] * f[0], v0[1] * f[1]); w.y = cvt_pk_bf16(v0[2] * f[2], v0[3] * f[3]); w.z = cvt_pk_bf16(v1[0] * f[4], v1[1] * f[5]); w.w = cvt_pk_bf16(v1[2] * f[6], v1[3] * f[7]);
                        *(u32x4*)(O + (size_t)(row0 + ai * HALF + m * 16) * LDM + col0 + bj * HALF) = w; }
            }
        }
    }
};

template <class Epi, class Sched>
__device__ __forceinline__ void gemm_phase(LAS unsigned char* lds, const Gemm g, const Sched& S, const Epi& E) {
    const int tid = fresh_tid(), wid = __builtin_amdgcn_readfirstlane(tid >> 6), lane = tid & 63, wr = wid >> 2, wc = wid & 3, fr = lane & 15, fq = lane >> 4;
    const int K = g.K, nt = K / BK;
    unsigned voffA[2], voffB[2];
#pragma unroll
    for (int i = 0; i < 2; ++i) { int R, C; stage_rc(tid * 16 + i * 8192, R, C); const int Rb = Epi::PERM ? ((R & ~31) + perm32(R & 31)) : R;
        voffA[i] = (unsigned)(R * g.lda + C) * 2u; voffB[i] = (unsigned)(Rb * g.ldb + C) * 2u; }
    const size_t kstep = (size_t)(BK * 2);
    const size_t hstepA = (size_t)HALF * g.lda * 2, hstepB = (size_t)HALF * g.ldb * 2;
    const size_t tstepA = 2 * hstepA, tstepB = 2 * hstepB;
    const unsigned ldsw = (unsigned)wid * 1024u;
    const int aoff = lds_byte(wr * 64 + fr, fq * 8), boff = lds_byte(wc * 32 + fr, fq * 8);
#define PG8_SA(b, h) (((b) * 2 + (h)) * HTB)
#define PG8_SB(b, h) ((4 + (b) * 2 + (h)) * HTB)
#define PG8_STAGE(bufoff, gbase, voff) do { _Pragma("unroll") for (int _i = 0; _i < 2; ++_i) \
        __builtin_amdgcn_global_load_lds((const unsigned*)((const char*)(gbase) + (voff)[_i]), (LAS unsigned*)(lds + (bufoff) + ldsw + _i * 8192), 16, 0, 0); } while (0)
#define PG8_LDA(dst, b, h) do { _Pragma("unroll") for (int m = 0; m < 4; ++m) _Pragma("unroll") for (int k = 0; k < 2; ++k) dst[m][k] = *(const LAS bf16x8*)(lds + PG8_SA(b, h) + aoff + m * 2048 + k * 1024); } while (0)
#define PG8_LDB(dst, b, h) do { _Pragma("unroll") for (int n = 0; n < 2; ++n) _Pragma("unroll") for (int k = 0; k < 2; ++k) dst[n][k] = *(const LAS bf16x8*)(lds + PG8_SB(b, h) + boff + n * 2048 + k * 1024); } while (0)
#define PG8_MMA(ai, bj, At, Bt) do { __builtin_amdgcn_s_setprio(1); _Pragma("unroll") for (int m = 0; m < 4; ++m) _Pragma("unroll") for (int n = 0; n < 2; ++n) _Pragma("unroll") for (int k = 0; k < 2; ++k) \
        acc[ai][bj][m][n] = __builtin_amdgcn_mfma_f32_16x16x32_bf16(Bt[n][k], At[m][k], acc[ai][bj][m][n], 0, 0, 0); __builtin_amdgcn_s_setprio(0); } while (0)
#define PG8_WAIT_V(n) asm volatile("s_waitcnt vmcnt(" #n ")" ::: "memory")
#define PG8_WAIT_L(n) asm volatile("s_waitcnt lgkmcnt(" #n ")" ::: "memory")
#define PG8_BAR __builtin_amdgcn_s_barrier()
#define PG8_SCHED __builtin_amdgcn_sched_barrier(0)
    Unit cur, nxt; int ui = 0;
    if (!S.next(0, cur)) return;
    f32x4 acc[2][2][4][2];
#pragma unroll
    for (int a = 0; a < 2; ++a)
#pragma unroll
        for (int b = 0; b < 2; ++b)
#pragma unroll
            for (int m = 0; m < 4; ++m)
#pragma unroll
                for (int n = 0; n < 2; ++n) acc[a][b][m][n] = (f32x4){0.f, 0.f, 0.f, 0.f};
    bf16x8 At[4][2], B0[2][2], B1[2][2];
    const char* cA = (const char*)g.A + (size_t)cur.seg * g.segA + (size_t)cur.pm * tstepA; const char* cB = (const char*)g.Bt + (size_t)cur.seg * g.segB + (size_t)cur.pn * tstepB;
    S.a_ready(cur);
    PG8_STAGE(PG8_SB(0, 0), cB, voffB); PG8_STAGE(PG8_SA(0, 0), cA, voffA); PG8_STAGE(PG8_SB(0, 1), cB + hstepB, voffB); PG8_STAGE(PG8_SA(0, 1), cA + hstepA, voffA);
    if (wr == 1) PG8_BAR;
    PG8_WAIT_V(4); PG8_BAR;
    PG8_STAGE(PG8_SB(1, 0), cB + kstep, voffB); PG8_STAGE(PG8_SA(1, 0), cA + kstep, voffA); PG8_STAGE(PG8_SB(1, 1), cB + hstepB + kstep, voffB);
    PG8_WAIT_V(6); PG8_BAR;
    for (;;) {
        E.prefetch(cur, lds, tid);
        const bool has_next = S.next(ui + 1, nxt);
        const char* nA = has_next ? (const char*)g.A + (size_t)nxt.seg * g.segA + (size_t)nxt.pm * tstepA : cA;
        const char* nB = has_next ? (const char*)g.Bt + (size_t)nxt.seg * g.segB + (size_t)nxt.pn * tstepB : cB;
        const int ntu = cur.nt ? cur.nt : nt;
        for (int t = 0; t < ntu; t += 2) {
            const bool last = (t == ntu - 2);
            const char* a1 = cA + (size_t)(t + 1) * kstep;
            const char* a2 = last ? nA : cA + (size_t)(t + 2) * kstep; const char* b2 = last ? nB : cB + (size_t)(t + 2) * kstep;
            const char* a3 = a2 + kstep; const char* b3 = b2 + kstep;
            if (last && has_next) S.a_ready(nxt);
            PG8_LDB(B0, 0, 0); PG8_SCHED; PG8_LDA(At, 0, 0); PG8_STAGE(PG8_SA(1, 1), a1 + hstepA, voffA);
            PG8_WAIT_L(8); PG8_BAR; PG8_WAIT_L(0); PG8_MMA(0, 0, At, B0); PG8_BAR; PG8_SCHED;
            PG8_LDB(B1, 0, 1); PG8_STAGE(PG8_SB(0, 0), b2, voffB);
            PG8_BAR; PG8_WAIT_L(0); PG8_MMA(0, 1, At, B1); PG8_BAR;
            PG8_LDA(At, 0, 1); PG8_STAGE(PG8_SA(0, 0), a2, voffA);
            PG8_BAR; PG8_WAIT_L(0); PG8_MMA(1, 0, At, B0); PG8_BAR; PG8_SCHED;
            PG8_STAGE(PG8_SB(0, 1), b2 + hstepB, voffB);
            PG8_WAIT_V(6); PG8_BAR; PG8_MMA(1, 1, At, B1); PG8_BAR;
            PG8_LDB(B0, 1, 0); PG8_SCHED; PG8_LDA(At, 1, 0); PG8_STAGE(PG8_SA(0, 1), a2 + hstepA, voffA);
            PG8_WAIT_L(8); PG8_BAR; PG8_WAIT_L(0); PG8_MMA(0, 0, At, B0); PG8_BAR; PG8_SCHED;
            PG8_LDB(B1, 1, 1); PG8_STAGE(PG8_SB(1, 0), b3, voffB);
            PG8_BAR; PG8_WAIT_L(0); PG8_MMA(0, 1, At, B1); PG8_BAR;
            PG8_LDA(At, 1, 1); PG8_STAGE(PG8_SA(1, 0), a3, voffA);
            PG8_BAR; PG8_WAIT_L(0); PG8_MMA(1, 0, At, B0); PG8_BAR; PG8_SCHED;
            PG8_STAGE(PG8_SB(1, 1), b3 + hstepB, voffB);
            PG8_WAIT_V(6); PG8_BAR; PG8_MMA(1, 1, At, B1); PG8_BAR;
        }
        E(acc, cur, wr, wc, fr, fq); S.done(cur);
#if defined(PROBE_EPI2)
        if constexpr (Epi::IDEMP && ((PROBE_EPI2 >> Epi::ID) & 1)) { asm volatile("" ::: "memory"); E(acc, cur, wr, wc, fr, fq); }
#endif
        if (!has_next) break;
        if (!E.keep(cur)) {
#pragma unroll
            for (int a = 0; a < 2; ++a)
#pragma unroll
                for (int b = 0; b < 2; ++b)
#pragma unroll
                    for (int m = 0; m < 4; ++m)
#pragma unroll
                        for (int n = 0; n < 2; ++n) acc[a][b][m][n] = (f32x4){0.f, 0.f, 0.f, 0.f};
        }
        cur = nxt; cA = nA; cB = nB; ++ui;
    }
    PG8_WAIT_V(0);
    if (wr == 0) PG8_BAR;
    PG8_BAR;
#undef PG8_SA
#undef PG8_SB
#undef PG8_STAGE
#undef PG8_LDA
#undef PG8_LDB
#undef PG8_MMA
#undef PG8_WAIT_V
#undef PG8_WAIT_L
#undef PG8_BAR
#undef PG8_SCHED
}
}

namespace att {
constexpr int NW = 8, QBLK = 32, KVBLK = 64, DV = 128;
constexpr float THR = 8.f;
#define SBAR() __builtin_amdgcn_sched_barrier(0)
__device__ __forceinline__ int crow(int r, int hi) { return (r & 3) + 8 * (r >> 2) + 4 * hi; }
__device__ __forceinline__ unsigned cvtpk(float lo, float hi) { return pg8::cvt_pk_bf16(lo, hi); }

__device__ __forceinline__ void partialSM(f32x16& p0, f32x16& p1, float& m_reg, float& mn, float& alpha, const float C, const float thr_s) {
  float pmax = p0[0];
#pragma unroll
  for (int r = 1; r < 16; ++r) pmax = fmaxf(pmax, p0[r]);
#pragma unroll
  for (int r = 0; r < 16; ++r) pmax = fmaxf(pmax, p1[r]);
  { auto rr = __builtin_amdgcn_permlane32_swap(__float_as_uint(pmax), __float_as_uint(pmax), false, false);
    pmax = fmaxf(__uint_as_float(rr[0]), __uint_as_float(rr[1])); }
  if (__builtin_expect(__all(pmax - m_reg <= thr_s), 1)) { mn = m_reg; alpha = 1.f; }
  else { mn = fmaxf(m_reg, pmax); alpha = __builtin_amdgcn_exp2f((m_reg - mn) * C); m_reg = mn; }
  float mnC = -mn * C;
#pragma unroll
  for (int r = 0; r < 16; ++r) p0[r] = fmaf(p0[r], C, mnC);
#pragma unroll
  for (int r = 0; r < 16; ++r) p1[r] = fmaf(p1[r], C, mnC);
#pragma unroll
  for (int r = 0; r < 16; ++r) p0[r] = __builtin_amdgcn_exp2f(p0[r]);
}
__device__ __forceinline__ void finishSM(f32x16& p0, f32x16& p1, float alpha, float& l_reg, bf16x8& pa0, bf16x8& pa1, bf16x8& pa2, bf16x8& pa3) {
#pragma unroll
  for (int r = 0; r < 16; ++r) p1[r] = __builtin_amdgcn_exp2f(p1[r]);
  float ps = 0;
#pragma unroll
  for (int r = 0; r < 16; ++r) ps += p0[r];
#pragma unroll
  for (int r = 0; r < 16; ++r) ps += p1[r];
  { auto rr = __builtin_amdgcn_permlane32_swap(__float_as_uint(ps), __float_as_uint(ps), false, false);
    ps = __uint_as_float(rr[0]) + __uint_as_float(rr[1]); }
  l_reg = l_reg * alpha + ps;
#define PK4(P, BASE, OUT) do { unsigned a0 = cvtpk(P[BASE + 0], P[BASE + 1]), a1 = cvtpk(P[BASE + 2], P[BASE + 3]);   \
    unsigned b0 = cvtpk(P[BASE + 4], P[BASE + 5]), b1 = cvtpk(P[BASE + 6], P[BASE + 7]);                              \
    auto r0 = __builtin_amdgcn_permlane32_swap(a0, b0, false, false); auto r1 = __builtin_amdgcn_permlane32_swap(a1, b1, false, false); \
    u32x4 w = {r0[0], r1[0], r0[1], r1[1]}; OUT = *reinterpret_cast<bf16x8*>(&w); } while (0)
  PK4(p0, 0, pa0); PK4(p0, 8, pa1); PK4(p1, 0, pa2); PK4(p1, 8, pa3);
#undef PK4
}
template <int DK>
__device__ __forceinline__ void qkt(f32x16& p0, f32x16& p1, const char* Ks, const bf16x8* qr, int r32, int hi) {
  p0 = f32x16{}; p1 = f32x16{};
#pragma unroll
  for (int d0 = 0; d0 < DK / 16; ++d0) { const int cb = (d0 * 16 + hi * 8) * 2;
    bf16x8 b0 = *reinterpret_cast<const bf16x8*>(Ks + r32 * (DK * 2) + (cb ^ ((r32 & 7) << 4)));
    bf16x8 b1 = *reinterpret_cast<const bf16x8*>(Ks + (32 + r32) * (DK * 2) + (cb ^ ((r32 & 7) << 4)));
    p0 = __builtin_amdgcn_mfma_f32_32x32x16_bf16(b0, qr[d0], p0, 0, 0, 0);
    p1 = __builtin_amdgcn_mfma_f32_32x32x16_bf16(b1, qr[d0], p1, 0, 0, 0); }
}
__device__ __forceinline__ int v_st(int k, int c) { const int kk = (k & ~0xC) | ((k & 4) << 1) | ((k & 8) >> 1); return ((kk >> 3) * 4 + (c >> 5)) * 512 + ((kk & 7) * 32 + (c & 31)) * 2; }
__device__ __forceinline__ int v_rd_base(int lane) { return ((lane & 3) << 3) | (((lane >> 2) & 3) << 6) | (((lane >> 4) & 1) << 5) | (((lane >> 5) & 1) << 8); }
constexpr int v_rd_off(int d0, int ks, int half) { return d0 * 512 + ks * 4096 + half * 2048; }
template <int OFF> __device__ __forceinline__ s16x4 tr_read(int vb) {
  s16x4 r; asm volatile("ds_read_b64_tr_b16 %0, %1 offset:%2" : "=&v"(r) : "v"(vb), "i"(OFF) : "memory"); return r;
}
template <int D0> __device__ __forceinline__ void pv_one(f32x16& od, int vb, bf16x8 pa0, bf16x8 pa1, bf16x8 pa2, bf16x8 pa3) {
  const s16x4 l0 = tr_read<v_rd_off(D0, 0, 0)>(vb), h0 = tr_read<v_rd_off(D0, 0, 1)>(vb), l1 = tr_read<v_rd_off(D0, 1, 0)>(vb), h1 = tr_read<v_rd_off(D0, 1, 1)>(vb);
  const s16x4 l2 = tr_read<v_rd_off(D0, 2, 0)>(vb), h2 = tr_read<v_rd_off(D0, 2, 1)>(vb), l3 = tr_read<v_rd_off(D0, 3, 0)>(vb), h3 = tr_read<v_rd_off(D0, 3, 1)>(vb);
  asm volatile("s_waitcnt lgkmcnt(0)" ::: "memory"); SBAR();
#define PK(L, H) (bf16x8){L[0], L[1], L[2], L[3], H[0], H[1], H[2], H[3]}
  od = __builtin_amdgcn_mfma_f32_32x32x16_bf16(pa0, PK(l0, h0), od, 0, 0, 0);
  od = __builtin_amdgcn_mfma_f32_32x32x16_bf16(pa1, PK(l1, h1), od, 0, 0, 0);
  od = __builtin_amdgcn_mfma_f32_32x32x16_bf16(pa2, PK(l2, h2), od, 0, 0, 0);
  od = __builtin_amdgcn_mfma_f32_32x32x16_bf16(pa3, PK(l3, h3), od, 0, 0, 0);
#undef PK
}
__device__ __forceinline__ void pv_d0(f32x16* o, int vb, bf16x8 pa0, bf16x8 pa1, bf16x8 pa2, bf16x8 pa3) {
  pv_one<0>(o[0], vb, pa0, pa1, pa2, pa3); pv_one<1>(o[1], vb, pa0, pa1, pa2, pa3); pv_one<2>(o[2], vb, pa0, pa1, pa2, pa3); pv_one<3>(o[3], vb, pa0, pa1, pa2, pa3);
}
__device__ __forceinline__ void ostore(float* p, float v) { *p = v; }
__device__ __forceinline__ void ostore(bf16_t* p, float v) { *p = (bf16_t)f2bf(v); }

template <int DK, int LDQ, int LDK, int LDV, int LDO, typename TOut, bool PIPE>
__device__ __forceinline__ void attn_body(const bf16_t* Qb, const bf16_t* Kh, const bf16_t* Vh, TOut* Ob, int seq, char* lds) {
  constexpr int SDEPTH = 1;
  constexpr int KPR = DK / 8;
  constexpr int KP = 64 * KPR / 512;
  constexpr size_t SHM_V = KVBLK * DV * 2, SHM_K = KVBLK * DK * 2;
  constexpr float SCALE = (DK == 128) ? 0.08838834764831845f : 0.07216878364870323f;
  constexpr float C = SCALE * 1.4426950408889634f, THR_S = THR / SCALE;
  const int tid = fresh_tid(), wid = tid >> 6, lane = tid & 63, r32 = lane & 31, hi = lane >> 5;
  char* V_lds = lds; char* K_lds = lds + 2 * SHM_V;
  float* ws = (float*)(lds + 2 * SHM_V + 2 * SHM_K) + wid * 64; float* li_l = ws; float* al_l = ws + 32;
  float m_reg = -1e30f, l_reg = 0; f32x16 o[4] = {}; bf16x8 qr[DK / 16];
  const bf16_t* Qw = Qb + (long)(wid * QBLK + r32) * LDQ + hi * 8;
#pragma unroll
  for (int d0 = 0; d0 < DK / 16; ++d0) qr[d0] = *reinterpret_cast<const bf16x8*>(Qw + d0 * 16);
  const int sr = tid >> 4, sc = (tid & 15) * 8, vst0 = v_st(sr, sc), vst1 = v_st(32 + sr, sc);
#define KROW(q) ((tid + 512 * (q)) / KPR)
#define KC8(q) ((tid + 512 * (q)) % KPR)
  const int vb0 = (int)(uintptr_t)V_lds + v_rd_base(lane);
  struct { bf16x8 vs0, vs1, ks[KP]; } sr_[SDEPTH];
  const unsigned voffV = (unsigned)(sr * LDV + sc) * 2u;
#define SLOAD(i, k0) do { const char* _vb = (const char*)Vh + (size_t)(k0) * (LDV * 2); const char* _kb = (const char*)Kh + (size_t)(k0) * (LDK * 2); \
    sr_[i].vs0 = *reinterpret_cast<const bf16x8*>(_vb + voffV); sr_[i].vs1 = *reinterpret_cast<const bf16x8*>(_vb + (size_t)32 * LDV * 2 + voffV); \
    _Pragma("unroll") for (int _q = 0; _q < KP; ++_q) sr_[i].ks[_q] = *reinterpret_cast<const bf16x8*>(_kb + (unsigned)(KROW(_q) * LDK + KC8(_q) * 8) * 2u); } while (0)
#define SWRITE(b, i) do { *(bf16x8*)(V_lds + (b) * SHM_V + vst0) = sr_[i].vs0; *(bf16x8*)(V_lds + (b) * SHM_V + vst1) = sr_[i].vs1; \
    _Pragma("unroll") for (int _q = 0; _q < KP; ++_q) *(bf16x8*)(K_lds + (b) * SHM_K + KROW(_q) * (DK * 2) + ((KC8(_q) * 16) ^ ((KROW(_q) & 7) << 4))) = sr_[i].ks[_q]; } while (0)
#define SWAIT() do { if constexpr (SDEPTH == 2) asm volatile("s_waitcnt vmcnt(4)" ::: "memory"); else asm volatile("s_waitcnt vmcnt(0)" ::: "memory"); } while (0)
#define RESC(a) do { if (__any((a) < 1.f)) { if (hi == 0) al_l[r32] = (a); asm volatile("s_waitcnt lgkmcnt(0)" ::: "memory"); \
    _Pragma("unroll") for (int d = 0; d < 4; ++d) _Pragma("unroll") for (int r = 0; r < 16; ++r) o[d][r] *= al_l[crow(r, hi)]; } } while (0)
  bf16x8 pa0, pa1, pa2, pa3; const int NT = seq / KVBLK;
  if constexpr (PIPE) {
  f32x16 pA0, pA1, pB0, pB1; float mnA, mnB, alA, alB;
  constexpr int SE = 0, SO = SDEPTH - 1;
  SLOAD(SE, 0); asm volatile("s_waitcnt vmcnt(0)" ::: "memory"); SWRITE(0, SE); __syncthreads();
  qkt<DK>(pA0, pA1, K_lds, qr, r32, hi); partialSM(pA0, pA1, m_reg, mnA, alA, C, THR_S);
  SLOAD(SO, KVBLK); if constexpr (SDEPTH == 2) { if (2 < NT) SLOAD(SE, 2 * KVBLK); }
  SWAIT(); SWRITE(1, SO); __syncthreads();
  for (int j = 1; j + 1 < NT; j += 2) {
    SBAR(); qkt<DK>(pB0, pB1, K_lds + SHM_K, qr, r32, hi);
    finishSM(pA0, pA1, alA, l_reg, pa0, pa1, pa2, pa3); SBAR();
    SLOAD(SO, (j + SDEPTH) * KVBLK); SBAR();
    pv_d0(o, vb0, pa0, pa1, pa2, pa3); partialSM(pB0, pB1, m_reg, mnB, alB, C, THR_S);
    __syncthreads(); SWAIT(); SWRITE(0, SE);
    RESC(alB); __syncthreads();
    SBAR(); qkt<DK>(pA0, pA1, K_lds, qr, r32, hi);
    finishSM(pB0, pB1, alB, l_reg, pa0, pa1, pa2, pa3); SBAR();
    if (SDEPTH == 1 || j + 3 < NT) SLOAD(SE, (j + 1 + SDEPTH) * KVBLK); SBAR();
    pv_d0(o, vb0 + (int)SHM_V, pa0, pa1, pa2, pa3); partialSM(pA0, pA1, m_reg, mnA, alA, C, THR_S);
    __syncthreads(); SWAIT(); SWRITE(1, SO);
    RESC(alA); __syncthreads();
  }
  SBAR(); qkt<DK>(pB0, pB1, K_lds + SHM_K, qr, r32, hi);
  finishSM(pA0, pA1, alA, l_reg, pa0, pa1, pa2, pa3); SBAR();
  pv_d0(o, vb0, pa0, pa1, pa2, pa3); partialSM(pB0, pB1, m_reg, mnB, alB, C, THR_S);
  __syncthreads(); RESC(alB);
  finishSM(pB0, pB1, alB, l_reg, pa0, pa1, pa2, pa3); SBAR();
  pv_d0(o, vb0 + (int)SHM_V, pa0, pa1, pa2, pa3);
  } else {
    f32x16 p0, p1; float mn, al;
    SLOAD(0, 0); asm volatile("s_waitcnt vmcnt(0)" ::: "memory"); SWRITE(0, 0); __syncthreads();
    for (int j = 0; j < NT; ++j) {
      const int bsel = j & 1;
      if (j + 1 < NT) SLOAD(0, (j + 1) * KVBLK);
      SBAR(); qkt<DK>(p0, p1, K_lds + bsel * SHM_K, qr, r32, hi);
      partialSM(p0, p1, m_reg, mn, al, C, THR_S);
      RESC(al);
      finishSM(p0, p1, al, l_reg, pa0, pa1, pa2, pa3); SBAR();
      pv_d0(o, vb0 + bsel * (int)SHM_V, pa0, pa1, pa2, pa3);
      if (j + 1 < NT) { asm volatile("s_waitcnt vmcnt(0)" ::: "memory"); SWRITE(bsel ^ 1, 0); }
      __syncthreads();
    }
  }
  if (hi == 0) li_l[r32] = l_reg; asm volatile("s_waitcnt lgkmcnt(0)" ::: "memory");
  float rli[16];
#pragma unroll
  for (int r = 0; r < 16; ++r) rli[r] = __builtin_amdgcn_rcpf(li_l[crow(r, hi)]);
  TOut* Ow = Ob + (long)(wid * QBLK) * LDO;
#pragma unroll
  for (int r = 0; r < 16; ++r) { const int orow = crow(r, hi);
#pragma unroll
    for (int d0 = 0; d0 < 4; ++d0) ostore(&Ow[(long)orow * LDO + d0 * 32 + r32], o[d0][r] * rli[r]); }
#undef SLOAD
#undef SWRITE
#undef SWAIT
#undef RESC
#undef KROW
#undef KC8
}

constexpr int VRS = 288;
template <int OFF> __device__ __forceinline__ s16x4 tr16(int vb) { return tr_read<OFF>(vb); }
__device__ __forceinline__ float xmax4(float v) {
  auto a = __builtin_amdgcn_permlane16_swap(__float_as_uint(v), __float_as_uint(v), false, false); v = fmaxf(__uint_as_float(a[0]), __uint_as_float(a[1]));
  auto b = __builtin_amdgcn_permlane32_swap(__float_as_uint(v), __float_as_uint(v), false, false); return fmaxf(__uint_as_float(b[0]), __uint_as_float(b[1]));
}
__device__ __forceinline__ float xsum4(float v) {
  auto a = __builtin_amdgcn_permlane16_swap(__float_as_uint(v), __float_as_uint(v), false, false); v = __uint_as_float(a[0]) + __uint_as_float(a[1]);
  auto b = __builtin_amdgcn_permlane32_swap(__float_as_uint(v), __float_as_uint(v), false, false); return __uint_as_float(b[0]) + __uint_as_float(b[1]);
}
template <int OFF> __device__ __forceinline__ bf16x8 lds_rd128(int addr) { bf16x8 r; asm volatile("ds_read_b128 %0, %1 offset:%2" : "=&v"(r) : "v"(addr), "i"(OFF) : "memory"); return r; }
template <int N> __device__ __forceinline__ void lgkm_wait() { asm volatile("s_waitcnt lgkmcnt(%0)" :: "i"(N) : "memory"); }
template <int DK, int D, int I> __device__ __forceinline__ void qk_ld(bf16x8 (&fr)[D + 1], const int (&ka)[DK / 32]) {
  constexpr int KS = DK / 32; fr[I % (D + 1)] = lds_rd128<(I / KS) * 16 * DK * 2>(ka[I % KS]);
}
template <int DK, int D, int I> __device__ __forceinline__ void qk_step(f32x4 (&s)[4][2], bf16x8 (&fr)[D + 1], const int (&ka)[DK / 32], const bf16x8 (&qr)[2][DK / 32]) {
  constexpr int KS = DK / 32, N = 4 * KS;
  if constexpr (I < N) {
    if constexpr (I + D < N) qk_ld<DK, D, I + D>(fr, ka);
    lgkm_wait<((N - 1 - I) < D ? (N - 1 - I) : D)>(); SBAR();
    constexpr int kt = I / KS, ks = I % KS;
    if constexpr (ks == 0) { s[kt][0] = __builtin_amdgcn_mfma_f32_16x16x32_bf16(fr[I % (D + 1)], qr[0][ks], (f32x4){0.f, 0.f, 0.f, 0.f}, 0, 0, 0); s[kt][1] = __builtin_amdgcn_mfma_f32_16x16x32_bf16(fr[I % (D + 1)], qr[1][ks], (f32x4){0.f, 0.f, 0.f, 0.f}, 0, 0, 0); }
    else { s[kt][0] = __builtin_amdgcn_mfma_f32_16x16x32_bf16(fr[I % (D + 1)], qr[0][ks], s[kt][0], 0, 0, 0); s[kt][1] = __builtin_amdgcn_mfma_f32_16x16x32_bf16(fr[I % (D + 1)], qr[1][ks], s[kt][1], 0, 0, 0); }
    SBAR();
    qk_step<DK, D, I + 1>(s, fr, ka, qr);
  }
}
template <int DK, int D, int I> __device__ __forceinline__ void qk_pro(bf16x8 (&fr)[D + 1], const int (&ka)[DK / 32]) { if constexpr (I < D) { qk_ld<DK, D, I>(fr, ka); qk_pro<DK, D, I + 1>(fr, ka); } }
template <int DK>
__device__ __forceinline__ void qkt16(f32x4 (&s)[4][2], const char* Ks, const bf16x8 (&qr)[2][DK / 32], int c, int g) {
  constexpr int D = 4; int ka[DK / 32]; bf16x8 fr[D + 1];
  const int kb = (int)(uintptr_t)Ks + c * (DK * 2);
#pragma unroll
  for (int ks = 0; ks < DK / 32; ++ks) ka[ks] = kb + (((ks * 32 + g * 8) * 2) ^ ((c & 7) << 4));
  qk_pro<DK, D, 0>(fr, ka); qk_step<DK, D, 0>(s, fr, ka, qr);
}
template <int DK, int D, int R> __device__ __forceinline__ void ql_ld(bf16x8 (&qa)[2][2], bf16x8 (&fr)[D + 1], const int (&qad)[DK / 32], const int (&kad)[DK / 32]) {
  constexpr int ks = R / 6, w = R % 6;
  if constexpr (w < 2) qa[ks & 1][w] = lds_rd128<w * 16 * DK * 2>(qad[ks]);
  else fr[(ks * 4 + (w - 2)) % (D + 1)] = lds_rd128<(w - 2) * 16 * DK * 2>(kad[ks]);
}
template <int DK, int D, int LO, int HI> __device__ __forceinline__ void ql_issue(bf16x8 (&qa)[2][2], bf16x8 (&fr)[D + 1], const int (&qad)[DK / 32], const int (&kad)[DK / 32]) {
  if constexpr (LO <= HI) { ql_ld<DK, D, LO>(qa, fr, qad, kad); ql_issue<DK, D, LO + 1, HI>(qa, fr, qad, kad); }
}
template <int DK, int D, int J> __device__ __forceinline__ void ql_step(f32x4 (&s)[4][2], bf16x8 (&qa)[2][2], bf16x8 (&fr)[D + 1], const int (&qad)[DK / 32], const int (&kad)[DK / 32]) {
  constexpr int KS = DK / 32, NR = 6 * KS, NJ = 4 * KS;
  if constexpr (J < NJ) {
    constexpr int ks = J / 4, kt = J % 4, rJ = 6 * ks + 2 + kt;
    constexpr int prevJ = J - 1, rP = J == 0 ? 0 : 6 * (prevJ / 4) + 2 + (prevJ % 4);
    constexpr int issuedP = (rP + D) < (NR - 1) ? (rP + D) : (NR - 1), issued = (rJ + D) < (NR - 1) ? (rJ + D) : (NR - 1);
    if constexpr (J > 0) ql_issue<DK, D, issuedP + 1, issued>(qa, fr, qad, kad);
    lgkm_wait<issued - rJ>(); SBAR();
    const bf16x8 kf = fr[(ks * 4 + kt) % (D + 1)];
    if constexpr (ks == 0) { s[kt][0] = __builtin_amdgcn_mfma_f32_16x16x32_bf16(kf, qa[0][0], (f32x4){0.f, 0.f, 0.f, 0.f}, 0, 0, 0); s[kt][1] = __builtin_amdgcn_mfma_f32_16x16x32_bf16(kf, qa[0][1], (f32x4){0.f, 0.f, 0.f, 0.f}, 0, 0, 0); }
    else { s[kt][0] = __builtin_amdgcn_mfma_f32_16x16x32_bf16(kf, qa[ks & 1][0], s[kt][0], 0, 0, 0); s[kt][1] = __builtin_amdgcn_mfma_f32_16x16x32_bf16(kf, qa[ks & 1][1], s[kt][1], 0, 0, 0); }
    SBAR();
    ql_step<DK, D, J + 1>(s, qa, fr, qad, kad);
  }
}
template <int DK>
__device__ __forceinline__ void qkt16l(f32x4 (&s)[4][2], const char* Ks, const char* Qs, int c, int g) {
  constexpr int D = 3; int qad[DK / 32], kad[DK / 32]; bf16x8 qa[2][2], fr[D + 1];
  const int kb = (int)(uintptr_t)Ks + c * (DK * 2), qb = (int)(uintptr_t)Qs + c * (DK * 2);
#pragma unroll
  for (int ks = 0; ks < DK / 32; ++ks) { const int sw = ((ks * 32 + g * 8) * 2) ^ ((c & 7) << 4); kad[ks] = kb + sw; qad[ks] = qb + sw; }
  ql_issue<DK, D, 0, 2 + D>(qa, fr, qad, kad);
  ql_step<DK, D, 0>(s, qa, fr, qad, kad);
}
__device__ __forceinline__ void partialSM16(f32x4 (&s)[4][2], float (&m_reg)[2], float (&alpha)[2], const float C, const float thr_s) {
  float pmax[2];
#pragma unroll
  for (int qt = 0; qt < 2; ++qt) { float v = s[0][qt][0];
#pragma unroll
    for (int kt = 0; kt < 4; ++kt)
#pragma unroll
      for (int r = 0; r < 4; ++r) v = fmaxf(v, s[kt][qt][r]);
    pmax[qt] = xmax4(v); }
  float mn[2];
  if (__builtin_expect(__all(pmax[0] - m_reg[0] <= thr_s && pmax[1] - m_reg[1] <= thr_s), 1)) { mn[0] = m_reg[0]; mn[1] = m_reg[1]; alpha[0] = 1.f; alpha[1] = 1.f; }
  else {
#pragma unroll
    for (int qt = 0; qt < 2; ++qt) { mn[qt] = fmaxf(m_reg[qt], pmax[qt]); alpha[qt] = __builtin_amdgcn_exp2f((m_reg[qt] - mn[qt]) * C); m_reg[qt] = mn[qt]; } }
#pragma unroll
  for (int qt = 0; qt < 2; ++qt) { const float mnC = -mn[qt] * C;
#pragma unroll
    for (int kt = 0; kt < 4; ++kt)
#pragma unroll
      for (int r = 0; r < 4; ++r) s[kt][qt][r] = fmaf(s[kt][qt][r], C, mnC); }
#pragma unroll
  for (int qt = 0; qt < 2; ++qt)
#pragma unroll
    for (int kt = 0; kt < 2; ++kt)
#pragma unroll
      for (int r = 0; r < 4; ++r) s[kt][qt][r] = __builtin_amdgcn_exp2f(s[kt][qt][r]);
}
__device__ __forceinline__ void finishSM16(f32x4 (&s)[4][2], const float (&alpha)[2], float (&lp)[2], bf16x8 (&pa)[2][2]) {
#pragma unroll
  for (int qt = 0; qt < 2; ++qt)
#pragma unroll
    for (int kt = 2; kt < 4; ++kt)
#pragma unroll
      for (int r = 0; r < 4; ++r) s[kt][qt][r] = __builtin_amdgcn_exp2f(s[kt][qt][r]);
#pragma unroll
  for (int qt = 0; qt < 2; ++qt) { float ps = 0.f;
#pragma unroll
    for (int kt = 0; kt < 4; ++kt) ps += (s[kt][qt][0] + s[kt][qt][1]) + (s[kt][qt][2] + s[kt][qt][3]);
    lp[qt] = lp[qt] * alpha[qt] + ps;
#pragma unroll
    for (int kb = 0; kb < 2; ++kb) { const f32x4 a = s[2 * kb][qt], b = s[2 * kb + 1][qt];
      u32x4 w = {cvtpk(a[0], a[1]), cvtpk(a[2], a[3]), cvtpk(b[0], b[1]), cvtpk(b[2], b[3])}; pa[qt][kb] = *reinterpret_cast<bf16x8*>(&w); } }
}
template <int VT, int VRSB> __device__ __forceinline__ void pv16_ld(s16x4 (&f)[4], int vb) {
  f[0] = tr16<0 * VRSB + VT * 32>(vb); f[1] = tr16<16 * VRSB + VT * 32>(vb); f[2] = tr16<32 * VRSB + VT * 32>(vb); f[3] = tr16<48 * VRSB + VT * 32>(vb);
}
template <int NVT, int VRSB, int DP, int VT> __device__ __forceinline__ void pv16_step(f32x4 (&o)[2][NVT], int vb, const bf16x8 (&pa)[2][2], s16x4 (&f)[DP + 1][4]) {
  if constexpr (VT < NVT) {
    if constexpr (VT + DP < NVT) pv16_ld<VT + DP, VRSB>(f[(VT + DP) % (DP + 1)], vb);
    lgkm_wait<4 * ((NVT - 1 - VT) < DP ? (NVT - 1 - VT) : DP)>(); SBAR();
    s16x4 (&fa)[4] = f[VT % (DP + 1)];
#define PK(L, H) (bf16x8){L[0], L[1], L[2], L[3], H[0], H[1], H[2], H[3]}
    o[0][VT] = __builtin_amdgcn_mfma_f32_16x16x32_bf16(pa[0][0], PK(fa[0], fa[1]), o[0][VT], 0, 0, 0);
    o[1][VT] = __builtin_amdgcn_mfma_f32_16x16x32_bf16(pa[1][0], PK(fa[0], fa[1]), o[1][VT], 0, 0, 0);
    o[0][VT] = __builtin_amdgcn_mfma_f32_16x16x32_bf16(pa[0][1], PK(fa[2], fa[3]), o[0][VT], 0, 0, 0);
    o[1][VT] = __builtin_amdgcn_mfma_f32_16x16x32_bf16(pa[1][1], PK(fa[2], fa[3]), o[1][VT], 0, 0, 0);
#undef PK
    SBAR();
    pv16_step<NVT, VRSB, DP, VT + 1>(o, vb, pa, f);
  }
}
template <int NVT, int VRSB, int DP, int VT> __device__ __forceinline__ void pv16_pro(int vb, s16x4 (&f)[DP + 1][4]) { if constexpr (VT < DP) { pv16_ld<VT, VRSB>(f[VT], vb); pv16_pro<NVT, VRSB, DP, VT + 1>(vb, f); } }
template <int NVT, int VRSB, int VT> __device__ __forceinline__ void pv16_plain(f32x4 (&o)[2][NVT], int vb, const bf16x8 (&pa)[2][2]) {
  if constexpr (VT < NVT) {
    s16x4 fa[4]; pv16_ld<VT, VRSB>(fa, vb); asm volatile("s_waitcnt lgkmcnt(0)" ::: "memory"); SBAR();
#define PK(L, H) (bf16x8){L[0], L[1], L[2], L[3], H[0], H[1], H[2], H[3]}
    o[0][VT] = __builtin_amdgcn_mfma_f32_16x16x32_bf16(pa[0][0], PK(fa[0], fa[1]), o[0][VT], 0, 0, 0);
    o[1][VT] = __builtin_amdgcn_mfma_f32_16x16x32_bf16(pa[1][0], PK(fa[0], fa[1]), o[1][VT], 0, 0, 0);
    o[0][VT] = __builtin_amdgcn_mfma_f32_16x16x32_bf16(pa[0][1], PK(fa[2], fa[3]), o[0][VT], 0, 0, 0);
    o[1][VT] = __builtin_amdgcn_mfma_f32_16x16x32_bf16(pa[1][1], PK(fa[2], fa[3]), o[1][VT], 0, 0, 0);
#undef PK
    pv16_plain<NVT, VRSB, VT + 1>(o, vb, pa);
  }
}
template <int NVT, int VRSB> __device__ __forceinline__ void pv16(f32x4 (&o)[2][NVT], int vb, const bf16x8 (&pa)[2][2]) {
  if constexpr (NVT <= 16) { constexpr int DP = NVT <= 8 ? 2 : 1; s16x4 f[DP + 1][4]; pv16_pro<NVT, VRSB, DP, 0>(vb, f); pv16_step<NVT, VRSB, DP, 0>(o, vb, pa, f); }
  else pv16_plain<NVT, VRSB, 0>(o, vb, pa);
}

template <int VT, int KB, int VRSB> __device__ __forceinline__ void pvh_ld(s16x4 (&f)[2], int vb) { f[0] = tr16<(32 * KB) * VRSB + VT * 32>(vb); f[1] = tr16<(32 * KB + 16) * VRSB + VT * 32>(vb); }
template <int NVT, int VRSB, int KB, int DH, int VT> __device__ __forceinline__ void pvh_pro(int vb, s16x4 (&f)[DH + 1][2]) { if constexpr (VT < DH && VT < NVT) { pvh_ld<VT, KB, VRSB>(f[VT], vb); pvh_pro<NVT, VRSB, KB, DH, VT + 1>(vb, f); } }
template <int NVT, int VRSB, int KB, int DH, bool EXPS, int VT> __device__ __forceinline__ void pvh_step(f32x4 (&o)[2][NVT], int vb, const bf16x8 (&pa)[2][2], s16x4 (&f)[DH + 1][2], f32x4 (&s)[4][2]) {
  if constexpr (VT < NVT) {
    if constexpr (VT + DH < NVT) pvh_ld<VT + DH, KB, VRSB>(f[(VT + DH) % (DH + 1)], vb);
    lgkm_wait<2 * ((NVT - 1 - VT) < DH ? (NVT - 1 - VT) : DH)>(); SBAR();
    s16x4 (&fa)[2] = f[VT % (DH + 1)];
    const bf16x8 vf = (bf16x8){fa[0][0], fa[0][1], fa[0][2], fa[0][3], fa[1][0], fa[1][1], fa[1][2], fa[1][3]};
    o[0][VT] = __builtin_amdgcn_mfma_f32_16x16x32_bf16(pa[0][KB], vf, o[0][VT], 0, 0, 0);
    o[1][VT] = __builtin_amdgcn_mfma_f32_16x16x32_bf16(pa[1][KB], vf, o[1][VT], 0, 0, 0);
    if constexpr (EXPS) { constexpr int EPS = 16 / NVT;
#pragma unroll
      for (int e = 0; e < EPS; ++e) { constexpr int dummy = 0; (void)dummy; const int idx = VT * EPS + e, kt = 2 + (idx >> 3), qt = (idx >> 2) & 1, r = idx & 3; s[kt][qt][r] = __builtin_amdgcn_exp2f(s[kt][qt][r]); } }
    SBAR();
    pvh_step<NVT, VRSB, KB, DH, EXPS, VT + 1>(o, vb, pa, f, s);
  }
}
__device__ __forceinline__ void cvt_pa(const f32x4 (&s)[4][2], bf16x8 (&pa)[2][2], int kb) {
#pragma unroll
  for (int qt = 0; qt < 2; ++qt) { const f32x4 a = s[2 * kb][qt], b = s[2 * kb + 1][qt];
    u32x4 w = {cvtpk(a[0], a[1]), cvtpk(a[2], a[3]), cvtpk(b[0], b[1]), cvtpk(b[2], b[3])}; pa[qt][kb] = *reinterpret_cast<bf16x8*>(&w); }
}

template <int DK, int DV, int LDQ, int LDK, int LDV, int LDO, typename TOut, bool PIPE, bool QL, bool VS>
__device__ __forceinline__ void attn_body16(const bf16_t* Qb, const bf16_t* Kh, const bf16_t* Vh, TOut* Ob, int seq, char* lds) {
  static_assert(!(PIPE && VS), "the pipelined loop needs two V buffers");
  constexpr int NVT = DV / 16, VRSB = DV * 2 + 32, NVB = VS ? 1 : 2;
  constexpr int KPR = DK / 8, KP = 64 * KPR / 512, VPR = DV / 8, VP = 64 * VPR / 512;
  constexpr size_t SHM_V = KVBLK * VRSB, SHM_K = KVBLK * DK * 2;
  constexpr float SCALE = (DK == 128) ? 0.08838834764831845f : 0.07216878364870323f;
  constexpr float C = SCALE * 1.4426950408889634f, THR_S = THR / SCALE;
  const int tid = fresh_tid(), wid = tid >> 6, lane = tid & 63, c = lane & 15, g = lane >> 4;
  char* V_lds = lds; char* K_lds = lds + NVB * SHM_V;
  char* Q_lds = lds + NVB * SHM_V + 2 * SHM_K + (size_t)wid * (QBLK * DK * 2);
  float* ws = (float*)(lds + NVB * SHM_V + 2 * SHM_K + (QL ? (size_t)NW * QBLK * DK * 2 : 0)) + wid * 64; float* li_l = ws; float* al_l = ws + 32;
  float m_reg[2] = {-1e30f, -1e30f}, lp[2] = {0.f, 0.f}; f32x4 o[2][NVT]; bf16x8 qr[QL ? 1 : 2][QL ? 1 : DK / 32];
#pragma unroll
  for (int qt = 0; qt < 2; ++qt)
#pragma unroll
    for (int vt = 0; vt < NVT; ++vt) o[qt][vt] = (f32x4){0.f, 0.f, 0.f, 0.f};
#pragma unroll
  for (int qt = 0; qt < 2; ++qt)
#pragma unroll
    for (int ks = 0; ks < DK / 32; ++ks) { const bf16x8 qv = *reinterpret_cast<const bf16x8*>(Qb + (long)(wid * QBLK + qt * 16 + c) * LDQ + ks * 32 + g * 8);
      if constexpr (QL) { *reinterpret_cast<bf16x8*>(Q_lds + (qt * 16 + c) * (DK * 2) + (((ks * 32 + g * 8) * 2) ^ ((c & 7) << 4))) = qv; if (qt == 0 && ks == 0) qr[0][0] = qv; } else qr[qt][ks] = qv; }
#define KROW(q) ((tid + 512 * (q)) / KPR)
#define KC8(q) ((tid + 512 * (q)) % KPR)
#define VROW(q) ((tid + 512 * (q)) / VPR)
#define VC8(q) ((tid + 512 * (q)) % VPR)
  const int vb0 = (int)(uintptr_t)V_lds + (4 * g + (c >> 2)) * VRSB + (c & 3) * 8;
  struct { bf16x8 vs[VP], ks[PIPE ? KP : 1]; } sr_;
  const int widu = __builtin_amdgcn_readfirstlane(wid);
#define SLOAD(k0) do { const char* _vb = (const char*)Vh + (size_t)(k0) * (LDV * 2); const char* _kb = (const char*)Kh + (size_t)(k0) * (LDK * 2); \
    _Pragma("unroll") for (int _q = 0; _q < VP; ++_q) sr_.vs[_q] = *reinterpret_cast<const bf16x8*>(_vb + (unsigned)(VROW(_q) * LDV + VC8(_q) * 8) * 2u); \
    _Pragma("unroll") for (int _q = 0; _q < KP; ++_q) sr_.ks[_q] = *reinterpret_cast<const bf16x8*>(_kb + (unsigned)(KROW(_q) * LDK + KC8(_q) * 8) * 2u); } while (0)
#define SWRITE2(bv, b) do { _Pragma("unroll") for (int _q = 0; _q < VP; ++_q) *(bf16x8*)(V_lds + (bv) * SHM_V + VROW(_q) * VRSB + VC8(_q) * 16) = sr_.vs[_q]; \
    _Pragma("unroll") for (int _q = 0; _q < KP; ++_q) *(bf16x8*)(K_lds + (b) * SHM_K + KROW(_q) * (DK * 2) + ((KC8(_q) * 16) ^ ((KROW(_q) & 7) << 4))) = sr_.ks[_q]; } while (0)
#define SWRITE(b) SWRITE2(b, b)
#define VLOAD(k0) do { const char* _vb = (const char*)Vh + (size_t)(k0) * (LDV * 2); \
    _Pragma("unroll") for (int _q = 0; _q < VP; ++_q) sr_.vs[_q] = *reinterpret_cast<const bf16x8*>(_vb + (unsigned)(VROW(_q) * LDV + VC8(_q) * 8) * 2u); } while (0)
#define VWRITE(bv) do { _Pragma("unroll") for (int _q = 0; _q < VP; ++_q) *(bf16x8*)(V_lds + (bv) * SHM_V + VROW(_q) * VRSB + VC8(_q) * 16) = sr_.vs[_q]; } while (0)
#define KDMA(k0, b) do { const char* _kb = (const char*)Kh + (size_t)(k0) * (LDK * 2); \
    _Pragma("unroll") for (int _q = 0; _q < KP; ++_q) { const int _r = KROW(_q), _c = KC8(_q) ^ (_r & 7); \
      __builtin_amdgcn_global_load_lds((const unsigned*)(_kb + (unsigned)(_r * LDK + _c * 8) * 2u), (LAS unsigned*)(unsigned)((unsigned)(uintptr_t)K_lds + (unsigned)((b) * SHM_K) + (unsigned)((widu * 64 + 512 * _q) * 16)), 16, 0, 0); } } while (0)
#define SWAIT() asm volatile("s_waitcnt vmcnt(0)" ::: "memory")
#define QKT(S, KS) do { if constexpr (QL) qkt16l<DK>(S, KS, Q_lds, c, g); else qkt16<DK>(S, KS, (const bf16x8 (&)[2][DK / 32])qr, c, g); } while (0)
#define RESC(a) do { if (__any((a)[0] < 1.f || (a)[1] < 1.f)) { if (g == 0) { al_l[c] = (a)[0]; al_l[16 + c] = (a)[1]; } asm volatile("s_waitcnt lgkmcnt(0)" ::: "memory"); \
    _Pragma("unroll") for (int qt = 0; qt < 2; ++qt) _Pragma("unroll") for (int r = 0; r < 4; ++r) { const float f = al_l[qt * 16 + 4 * g + r]; \
      _Pragma("unroll") for (int vt = 0; vt < NVT; ++vt) o[qt][vt][r] *= f; } } } while (0)
  bf16x8 pa[2][2]; const int NT = seq / KVBLK;
  if constexpr (PIPE) {
    f32x4 sA[4][2], sB[4][2]; float alA[2], alB[2];
    SLOAD(0); asm volatile("s_waitcnt vmcnt(0)" ::: "memory"); SWRITE(0); __syncthreads();
    QKT(sA, K_lds); partialSM16(sA, m_reg, alA, C, THR_S);
    SLOAD(KVBLK);
    SWAIT(); SWRITE(1); __syncthreads();
    for (int j = 1; j + 1 < NT; j += 2) {
      SLOAD((j + 1) * KVBLK); SBAR(); QKT(sB, K_lds + SHM_K); SBAR();
      finishSM16(sA, alA, lp, pa); SBAR();
      pv16<NVT, VRSB>(o, vb0, pa); partialSM16(sB, m_reg, alB, C, THR_S);
      __syncthreads(); SWAIT(); SWRITE(0);
      RESC(alB); __syncthreads();
      SLOAD((j + 2) * KVBLK); SBAR(); QKT(sA, K_lds); SBAR();
      finishSM16(sB, alB, lp, pa); SBAR();
      pv16<NVT, VRSB>(o, vb0 + (int)SHM_V, pa); partialSM16(sA, m_reg, alA, C, THR_S);
      __syncthreads(); SWAIT(); SWRITE(1);
      RESC(alA); __syncthreads();
    }
    SBAR(); QKT(sB, K_lds + SHM_K); SBAR();
    finishSM16(sA, alA, lp, pa); SBAR();
    pv16<NVT, VRSB>(o, vb0, pa); partialSM16(sB, m_reg, alB, C, THR_S);
    __syncthreads(); RESC(alB);
    finishSM16(sB, alB, lp, pa); SBAR();
    pv16<NVT, VRSB>(o, vb0 + (int)SHM_V, pa);
  } else {
    f32x4 s[4][2]; float al[2];
    VLOAD(0); KDMA(0, 0); asm volatile("s_waitcnt vmcnt(0)" ::: "memory"); VWRITE(0); __syncthreads();
    for (int j = 0; j < NT; ++j) {
      const int bsel = j & 1, vsel = VS ? 0 : bsel;
      if (j + 1 < NT) { VLOAD((j + 1) * KVBLK); KDMA((j + 1) * KVBLK, bsel ^ 1); }
      SBAR(); QKT(s, K_lds + bsel * SHM_K);
      partialSM16(s, m_reg, al, C, THR_S);
      RESC(al);
      constexpr int DH = 3; s16x4 pvf[DH + 1][2]; const int vbt = vb0 + vsel * (int)SHM_V;
      pvh_pro<NVT, VRSB, 0, DH, 0>(vbt, pvf); SBAR();
      cvt_pa(s, pa, 0); SBAR();
      pvh_step<NVT, VRSB, 0, DH, true, 0>(o, vbt, pa, pvf, s);
      pvh_pro<NVT, VRSB, 1, DH, 0>(vbt, pvf); SBAR();
#pragma unroll
      for (int qt = 0; qt < 2; ++qt) { float ps = 0.f;
#pragma unroll
        for (int kt = 0; kt < 4; ++kt) ps += (s[kt][qt][0] + s[kt][qt][1]) + (s[kt][qt][2] + s[kt][qt][3]);
        lp[qt] = lp[qt] * al[qt] + ps; }
      cvt_pa(s, pa, 1); SBAR();
      pvh_step<NVT, VRSB, 1, DH, false, 0>(o, vbt, pa, pvf, s);
      if constexpr (VS) {
        asm volatile("s_waitcnt vmcnt(0)" ::: "memory");
        __syncthreads();
        if (j + 1 < NT) VWRITE(0);
      } else if (j + 1 < NT) { asm volatile("s_waitcnt vmcnt(0)" ::: "memory"); VWRITE(bsel ^ 1); }
      __syncthreads();
    }
  }
  { const float l0 = xsum4(lp[0]), l1 = xsum4(lp[1]); if (g == 0) { li_l[c] = l0; li_l[16 + c] = l1; } }
  asm volatile("s_waitcnt lgkmcnt(0)" ::: "memory");
  { constexpr int ESZ = (int)sizeof(TOut), RS = 272, CP = 256 / ESZ, NVTP = CP / 16, NPASS = DV / CP;
    LAS char* stg = (LAS char*)(unsigned)((unsigned)(uintptr_t)lds + (unsigned)wid * (32u * RS));
    float rl[2][4];
#pragma unroll
    for (int qt = 0; qt < 2; ++qt)
#pragma unroll
      for (int r = 0; r < 4; ++r) rl[qt][r] = __builtin_amdgcn_rcpf(li_l[qt * 16 + 4 * g + r]);
    TOut* Ow = Ob + (long)(wid * QBLK) * LDO;
#pragma unroll
    for (int pass = 0; pass < NPASS; ++pass) {
#pragma unroll
      for (int qt = 0; qt < 2; ++qt)
#pragma unroll
        for (int r = 0; r < 4; ++r)
#pragma unroll
          for (int v = 0; v < NVTP; ++v) { const float val = o[qt][pass * NVTP + v][r] * rl[qt][r]; LAS char* p = stg + (qt * 16 + 4 * g + r) * RS + (v * 16 + c) * ESZ;
            if constexpr (ESZ == 2) *(LAS unsigned short*)p = (unsigned short)cvtpk(val, 0.f); else *(LAS float*)p = val; }
#pragma unroll
      for (int i = 0; i < 8; ++i) { const int row = i * 4 + (lane >> 4), ch = lane & 15;
        const u32x4 w = *(const LAS u32x4*)(stg + row * RS + ch * 16);
        *(u32x4*)((char*)(Ow + (long)row * LDO + pass * CP) + ch * 16) = w; }
    }
  }
#undef SLOAD
#undef SWRITE
#undef SWRITE2
#undef VLOAD
#undef VWRITE
#undef KDMA
#undef SWAIT
#undef RESC
#undef QKT
#undef KROW
#undef KC8
#undef VROW
#undef VC8
}
}

struct Args { const float* in[27]; int s_lo, s_hi; };
enum { I_X = 0, I_C, I_CTX, I_CCTX, I_ADAW, I_ADAB, I_WIN, I_QN, I_WUQ, I_KVN, I_WUKV, I_SLNG, I_SLNB, I_SW, I_SB, I_DLAM, I_DSUB, I_WBR, I_WOUT, I_LN1G, I_LN1B, I_WGU, I_WDN, I_LN2G, I_LN2B, I_OUT_, I_WS_ };

struct RowId { int off; __device__ __forceinline__ int operator()(int n) const { return off + n; } };
struct RowGU { __device__ __forceinline__ int operator()(int n) const { const int up = n >= FF, j = up ? n - FF : n; return (j >> 7) * 256 + up * 128 + (j & 127); } };
struct RowWin { __device__ __forceinline__ int operator()(int n) const {
    if (n < 1024) return n;
    if (n < 1088) { const int r = n - 1024, a = r >> 5, wh = (r >> 4) & 1, i = r & 15; return NKR + a * 32 + 2 * i + wh; }
    if (n < 3136) return n - 64;
    if (n < 5184) { const int r = n - 3136, blk = r >> 7, d = r & 127, a = d >> 6, wh = (d >> 5) & 1, i = d & 31; return NDQ + blk * 128 + a * 64 + 2 * i + wh; }
    return n - 64; } };
struct RowUQ { __device__ __forceinline__ int operator()(int n) const { const int h = n / 192, d = n - h * 192; if (d < 128) return n;
    const int r = d - 128, a = r >> 5, wh = (r >> 4) & 1, i = r & 15; return h * 192 + 128 + a * 32 + 2 * i + wh; } };
struct RowUKV { __device__ __forceinline__ int operator()(int n) const { const int h = n >> 8, d = n & 255; return d < 128 ? h * 128 + d : 1024 + h * 128 + (d - 128); } };
template <class RowMap>
__device__ __forceinline__ void transpose_item(const float* W, int K, int N, int ldw, bf16_t* WT, const RowMap& rm, LAS float* scr, int item, int lane, const float* kscale = nullptr) {
    const int nblk = N / 64, kb = item / nblk, nb = item % nblk, k0 = 64 * kb, n0 = 64 * nb;
    f32x4 v[16]; float ksc[16];
#pragma unroll
    for (int i = 0; i < 16; ++i) { const int kk = 4 * i + (lane >> 4), c4 = (lane & 15) * 4;
        v[i] = *(const f32x4*)(W + (size_t)(k0 + kk) * ldw + n0 + c4); ksc[i] = kscale ? kscale[k0 + kk] : 1.0f; }
    __builtin_amdgcn_sched_barrier(0);
#pragma unroll
    for (int i = 0; i < 16; ++i) { const int kk = 4 * i + (lane >> 4), c4 = (lane & 15) * 4; const f32x4 w = kscale ? v[i] * ksc[i] : v[i];
        scr[kk * 65 + c4] = w[0]; scr[kk * 65 + c4 + 1] = w[1]; scr[kk * 65 + c4 + 2] = w[2]; scr[kk * 65 + c4 + 3] = w[3]; }
    asm volatile("s_waitcnt lgkmcnt(0)" ::: "memory");
    const int c = lane & 7;
#pragma unroll
    for (int j = 0; j < 8; ++j) { const int n = (lane >> 3) + 8 * j; const LAS float* s = scr + (8 * c) * 65 + n;
        u32x4 o; o.x = pk2(s[0 * 65], s[1 * 65]); o.y = pk2(s[2 * 65], s[3 * 65]); o.z = pk2(s[4 * 65], s[5 * 65]); o.w = pk2(s[6 * 65], s[7 * 65]);
        *(u32x4*)(WT + (size_t)rm(n0 + n) * K + k0 + 8 * c) = o; }
    asm volatile("s_waitcnt lgkmcnt(0)" ::: "memory");
}

template <int NP> __device__ __forceinline__ void sum_parts(const bf16_t* PART, bf16_t* MIX, int lane, int gw, int NGW) {
    for (int tp = 8192 + gw; tp < T / 2; tp += NGW)
#pragma unroll 1
    for (int rr = 0; rr < 2; ++rr) { const int r = 2 * (tp - 8192) + rr;
        u32x4 w[NP][4];
#pragma unroll
        for (int s = 0; s < NP; ++s)
#pragma unroll
            for (int i = 0; i < 4; ++i) w[s][i] = *(const u32x4*)(PART + ((size_t)s * 1024 + r) * LDM + (lane + 64 * i) * 8);
#pragma unroll
        for (int i = 0; i < 4; ++i) { float a[8] = {0.f, 0.f, 0.f, 0.f, 0.f, 0.f, 0.f, 0.f};
#pragma unroll
            for (int s = 0; s < NP; ++s) { float f[8]; unpack8(w[s][i], f);
#pragma unroll
                for (int e = 0; e < 8; ++e) a[e] += f[e]; }
            *(u32x4*)(MIX + (size_t)(64 * 256 + r) * LDM + (lane + 64 * i) * 8) = pack8(a); }
    }
}
template <int WHICH>
__device__ __forceinline__ void ln_phase(const Args& args, int l, const float* mod_l, float* H, bf16_t* MIX, const bf16_t* PART, bf16_t* XM, int lane, int gw, int NGW) {
    if (l < DEPTH - 1) { if (WHICH == 0) sum_parts<8>(PART, MIX, lane, gw, NGW); else sum_parts<4>(PART, MIX, lane, gw, NGW);
        __builtin_amdgcn_fence(__ATOMIC_SEQ_CST, "workgroup"); }

    const float* lg = args.in[(WHICH ? I_LN2G : I_LN1G)] + (size_t)l * DM; const float* lb = args.in[(WHICH ? I_LN2B : I_LN1B)] + (size_t)l * DM;
    for (int tp = gw; tp < T / 2; tp += NGW) {
        const int t = 2 * tp, b = t / TPB, j = t - b * TPB, mrow = j < CTXL ? 4 : b;
        if (l == DEPTH - 1 && j < CTXL) continue;
        const float* mr = mod_l + (size_t)mrow * 6 * DM; const float* gate = mr + (WHICH ? 5 : 2) * DM;
        const float* hin = (WHICH == 0 && l == 0) ? (j < CTXL ? args.in[I_CTX] + ((size_t)b * CTXL + j) * DM : args.in[I_X] + ((size_t)b * SEQ + (j - CTXL)) * DM) : H + (size_t)t * DM;
        f32x4 v[2][8]; float sum0 = 0.f, sum1 = 0.f;
#pragma unroll
        for (int hb = 0; hb < 2; ++hb) {
            f32x4 gt[4], hv[2][4]; u32x2 mw[2][4];
#pragma unroll
            for (int i4 = 0; i4 < 4; ++i4) { const int d = lane * 4 + 256 * (hb * 4 + i4); gt[i4] = *(const f32x4*)(gate + d);
#pragma unroll
                for (int r = 0; r < 2; ++r) { mw[r][i4] = *(const u32x2*)(MIX + (size_t)(t + r) * LDM + d); hv[r][i4] = *(const f32x4*)(hin + (size_t)r * DM + d); } }
            __builtin_amdgcn_sched_barrier(0);
#pragma unroll
            for (int i4 = 0; i4 < 4; ++i4) { const int i = hb * 4 + i4;
#pragma unroll
                for (int r = 0; r < 2; ++r) { const u32x2 w = mw[r][i4];
                    const f32x4 mx = {__uint_as_float(w.x << 16), __uint_as_float(w.x & 0xffff0000u), __uint_as_float(w.y << 16), __uint_as_float(w.y & 0xffff0000u)};
                    v[r][i] = hv[r][i4] * ALPHA + gt[i4] * mx; }
                sum0 += (v[0][i][0] + v[0][i][1]) + (v[0][i][2] + v[0][i][3]); sum1 += (v[1][i][0] + v[1][i][1]) + (v[1][i][2] + v[1][i][3]); }
            __builtin_amdgcn_sched_barrier(0);
        }
        const float mean0 = wave_sum(sum0, lane) * (1.0f / DM), mean1 = wave_sum(sum1, lane) * (1.0f / DM); float sq0 = 0.f, sq1 = 0.f;
#pragma unroll
        for (int i = 0; i < 8; ++i) { v[0][i] = v[0][i] - mean0; v[1][i] = v[1][i] - mean1;
            sq0 += (v[0][i][0] * v[0][i][0] + v[0][i][1] * v[0][i][1]) + (v[0][i][2] * v[0][i][2] + v[0][i][3] * v[0][i][3]);
            sq1 += (v[1][i][0] * v[1][i][0] + v[1][i][1] * v[1][i][1]) + (v[1][i][2] * v[1][i][2] + v[1][i][3] * v[1][i][3]); }
        const float rstd[2] = {rsqrtf(wave_sum(sq0, lane) * (1.0f / DM) + EPS), rsqrtf(wave_sum(sq1, lane) * (1.0f / DM) + EPS)};
#pragma unroll
        for (int hb = 0; hb < 2; ++hb) {
            f32x4 g4[4], b4[4], ms[4], ma[4];
#pragma unroll
            for (int i4 = 0; i4 < 4; ++i4) { const int d = lane * 4 + 256 * (hb * 4 + i4);
                g4[i4] = *(const f32x4*)(lg + d); b4[i4] = *(const f32x4*)(lb + d); ms[i4] = (f32x4){0.f, 0.f, 0.f, 0.f}; ma[i4] = ms[i4];
                if (WHICH == 0) { ms[i4] = *(const f32x4*)(mr + 4 * DM + d); ma[i4] = *(const f32x4*)(mr + 3 * DM + d); }
                else if (l < DEPTH - 1) { const float* mn = mr + 5 * 6 * DM; ms[i4] = *(const f32x4*)(mn + DM + d); ma[i4] = *(const f32x4*)(mn + d); } }
            __builtin_amdgcn_sched_barrier(0);
#pragma unroll
            for (int i4 = 0; i4 < 4; ++i4) { const int i = hb * 4 + i4, d = lane * 4 + 256 * i;
#pragma unroll
                for (int r = 0; r < 2; ++r) {
                    const f32x4 y = v[r][i] * rstd[r] * g4[i4] + b4[i4];
                    if (WHICH == 0 || l < DEPTH - 1) { *(f32x4*)(H + (size_t)(t + r) * DM + d) = y;
                        const f32x4 x2 = y * (ms[i4] + 1.0f) + ma[i4]; u32x2 w; w.x = pk2(x2[0], x2[1]); w.y = pk2(x2[2], x2[3]); *(u32x2*)(XM + (size_t)(t + r) * DM + d) = w; }
                    else *(f32x4*)((float*)args.in[I_OUT_] + ((size_t)b * SEQ + (j + r - CTXL)) * DM + d) = y; } }
            __builtin_amdgcn_sched_barrier(0);
        }
    }
}

__global__ void __launch_bounds__(512, 2) mk_fwd(Args args) {
    extern __shared__ __attribute__((aligned(16))) unsigned char lds[];
    const int G = gridDim.x, NGW = G * 8;
#define FRESH() const int tid = fresh_tid(), lane = tid & 63, wave = __builtin_amdgcn_readfirstlane(tid >> 6), gw = blockIdx.x * 8 + wave; (void)lane; (void)wave; (void)gw; PTRS(); const float* mod_l = MOD + (size_t)l * 5 * 6 * DM; (void)mod_l
    unsigned char* ws0 = (unsigned char*)args.in[I_WS_];
#define PTRS() \
    const int zz = fresh_zero(); unsigned char* ws = (unsigned char*)args.in[I_WS_ + zz]; (void)ws; \
    float* MOD = (float*)(ws + WS_MOD); \
    float* LAM = (float*)(ws + WS_MISC); \
    float2* TAB128 = (float2*)(ws + WS_MISC + 1024); \
    float2* TAB64 = (float2*)(ws + WS_MISC + 1024 + 16384); \
    bf16_t* WB = (bf16_t*)(ws + WS_WB); \
    float* H = (float*)(ws + WS_H); \
    bf16_t* XM = (bf16_t*)(ws + WS_XM); \
    bf16_t* Z = (bf16_t*)(ws + WS_Z); bf16_t* GNB = (bf16_t*)(ws + WS_GN); \
    bf16_t* QM = (bf16_t*)(ws + WS_B + B_QM); bf16_t* KM = (bf16_t*)(ws + WS_B + B_KM); bf16_t* VM = (bf16_t*)(ws + WS_B + B_VM); \
    float* SSQ = (float*)(ws + WS_B + B_SSQ); float2* SVS = (float2*)(ws + WS_B + B_SVS); \
    bf16_t* Y3 = (bf16_t*)(ws + WS_B + B_Y3); \
    float* OD = (float*)(ws + WS_B + B_OD); \
    bf16_t* HH = (bf16_t*)(ws + WS_B); \
    bf16_t* MRG = (bf16_t*)(ws + WS_MRG); \
    bf16_t* MIX = (bf16_t*)(ws + WS_MIX); bf16_t* PART = (bf16_t*)(ws + WS_PART);
    volatile LAS unsigned* MISCW = (volatile LAS unsigned*)((LAS unsigned char*)lds + LDS_MISC);
    if (threadIdx.x < 64) MISCW[threadIdx.x] = 0u;
    __syncthreads();
    if (!MK_PER_PHASE) (void)xcd_barrier_post((unsigned*)(ws0 + WS_CTL) + 4096, MISCW + 8);

    const int s_lo = args.s_lo, s_hi = args.s_hi;
#ifndef PH_MASK
#define PH_MASK 0xfff
#endif
#define IN(s) (((PH_MASK >> ((s) % NPH)) & 1) && s_lo <= (s) && (s) < s_hi)
#ifndef PROBE_DUP
#define PROBE_DUP 0
#endif
#define DUPF(ph) (((PROBE_DUP >> (ph)) & 1) ? 2 : 1)
#define REP(ph) for (int _rep = 0; _rep < (((PROBE_DUP >> (ph)) & 1) ? 2 : 1); ++_rep)
#define SEAM(s) do { if (IN((s) + 1)) { XcdBarrier _b; _b.bar = (unsigned*)((unsigned char*)args.in[I_WS_ + fresh_zero()] + WS_CTL) + 4096; _b.x = xb_xcc_id(); _b.st = (volatile LAS unsigned*)((LAS unsigned char*)lds + LDS_MISC) + 8; xcd_barrier(_b); } } while (0)

    for (int l = 0; l < DEPTH; ++l) {
        const int sb = l * NPH;

        if (IN(sb + PH_CONV)) {
            FRESH();
            LAS float* scr = (LAS float*)((LAS unsigned char*)lds + wave * 16640);
            const float* w_in = args.in[I_WIN + zz] + (size_t)l * DM * INW;
            const float* w_uq = args.in[I_WUQ + zz] + (size_t)l * 512 * 1536;
            const float* w_ukv = args.in[I_WUKV + zz] + (size_t)l * 512 * 2048;
            const float* w_br = args.in[I_WBR + zz] + (size_t)l * 3 * 1024 * DM;
            const float* w_out = args.in[I_WOUT + zz] + (size_t)l * DM * DM;
            const float* w_gu = args.in[I_WGU + zz] + (size_t)l * DM * 2 * FF;
            const float* w_dn = args.in[I_WDN + zz] + (size_t)l * FF * DM;
            constexpr int I_IN = (DM / 64) * (INW / 64), I_UQ = (512 / 64) * (1536 / 64), I_UKV = (512 / 64) * (2048 / 64), I_BR = (1024 / 64) * (DM / 64),
                          I_OUT = (DM / 64) * (DM / 64), I_GU = (DM / 64) * (2 * FF / 64), I_DN = (FF / 64) * (DM / 64);
            constexpr int NITEMS = I_IN + I_UQ + I_UKV + 3 * I_BR + I_OUT + I_GU + I_DN;
            REP(PH_CONV) for (int it = gw; it < NITEMS; it += NGW) {
                int r = it;
                if (r < I_IN) { transpose_item(w_in, DM, INW, INW, WB + WE_IN, RowWin{}, scr, r, lane); continue; } r -= I_IN;
                if (r < I_UQ) { transpose_item(w_uq, 512, 1536, 1536, WB + WE_UQ, RowUQ{}, scr, r, lane, args.in[I_QN + zz] + (size_t)l * 512); continue; } r -= I_UQ;
                if (r < I_UKV) { transpose_item(w_ukv, 512, 2048, 2048, WB + WE_UKV, RowUKV{}, scr, r, lane, args.in[I_KVN + zz] + (size_t)l * 512); continue; } r -= I_UKV;
                if (r < 3 * I_BR) { const int n = r / I_BR; transpose_item(w_br + (size_t)n * 1024 * DM, 1024, DM, DM, WB + WE_BR + (size_t)n * DM * 1024, RowId{0}, scr, r - n * I_BR, lane); continue; } r -= 3 * I_BR;
                if (r < I_OUT) { transpose_item(w_out, DM, DM, DM, WB + WE_OUT, RowId{0}, scr, r, lane); continue; } r -= I_OUT;
                if (r < I_GU) { transpose_item(w_gu, DM, 2 * FF, 2 * FF, WB + WE_GU, RowGU{}, scr, r, lane); continue; } r -= I_GU;
                transpose_item(w_dn, FF, DM, DM, WB + WE_DN, RowId{0}, scr, r, lane);
            }
            for (int i = blockIdx.x * 512 + tid; i < (ZW - NKR - 64) * DM / 8; i += G * 512) *(u32x4*)(WB + WE_IN + (size_t)(NKR + 64) * DM + (size_t)i * 8) = (u32x4){(unsigned)zz, (unsigned)zz, (unsigned)zz, (unsigned)zz};
            if (l == 0) {
                __syncthreads();
                LAS float* sl = (LAS float*)lds;
                LAS float* red = (LAS float*)(lds + 40960);
                for (int i = tid; i < 5 * DM; i += 512) { const int r = i / DM, k = i - r * DM; const float v = r < 4 ? args.in[I_C + zz][r * DM + k] : args.in[I_CCTX + zz][k]; sl[i] = v / (1.0f + __expf(-v)); }
                __syncthreads();
                const int nq = tid & 15, ks = tid >> 4;
                REP(14) for (int unit = blockIdx.x; unit < DEPTH * 192; unit += G) {
                    const int lp = unit / 192, n0 = (unit - lp * 192) * 64;
                    const float* wbase = args.in[I_ADAW + zz] + (size_t)lp * DM * (6 * DM) + n0 + 4 * nq;
                    f32x4 a0 = {0, 0, 0, 0}, a1 = a0, a2 = a0, a3 = a0, a4 = a0;
#pragma unroll 8
                    for (int k = ks * 64; k < ks * 64 + 64; ++k) {
                        const f32x4 w = *(const f32x4*)(wbase + (size_t)k * (6 * DM));
                        a0 += w * sl[k]; a1 += w * sl[DM + k]; a2 += w * sl[2 * DM + k]; a3 += w * sl[3 * DM + k]; a4 += w * sl[4 * DM + k];
                    }
                    *(LAS f32x4*)(red + (ks * 5 + 0) * 64 + 4 * nq) = a0; *(LAS f32x4*)(red + (ks * 5 + 1) * 64 + 4 * nq) = a1; *(LAS f32x4*)(red + (ks * 5 + 2) * 64 + 4 * nq) = a2;
                    *(LAS f32x4*)(red + (ks * 5 + 3) * 64 + 4 * nq) = a3; *(LAS f32x4*)(red + (ks * 5 + 4) * 64 + 4 * nq) = a4;
                    __syncthreads();
                    if (tid < 320) { const int r = tid >> 6, c = tid & 63; float s = args.in[I_ADAB + zz][(size_t)lp * 6 * DM + n0 + c];
                        for (int q = 0; q < 32; ++q) s += red[(q * 5 + r) * 64 + c];
                        MOD[((size_t)lp * 5 + r) * 6 * DM + n0 + c] = s; }
                    __syncthreads();
                }
                if (blockIdx.x == 0 && tid < DEPTH) {
                    const float* lp = args.in[I_DLAM + zz] + (size_t)tid * 4 * 128; float s1 = 0.f, s2 = 0.f;
                    for (int i = 0; i < 128; ++i) { s1 += lp[i] * lp[128 + i]; s2 += lp[256 + i] * lp[384 + i]; }
                    const float li = 0.8f - 0.6f * expf(-0.3f * (float)tid);
                    LAM[tid] = expf(s1) - expf(s2) + li; LAM[4 + tid] = li;
                }
                if (blockIdx.x == 1 % G) {
                    for (int i = tid; i < 64 * 32; i += 512) { const int pos = i >> 5, f = i & 31; const float ang = (float)pos * exp2f(-(float)f * (13.287712379549449f / 32.0f)); TAB128[i] = make_float2(cosf(ang), sinf(ang)); }
                    for (int i = tid; i < 64 * 16; i += 512) { const int pos = i >> 4, f = i & 15; const float ang = (float)pos * exp2f(-(float)f * (13.287712379549449f / 16.0f)); TAB64[i] = make_float2(cosf(ang), sinf(ang)); }
                }
            }
            SEAM(sb + PH_CONV);
        }

        if (l == 0 && IN(sb + PH_INIT)) {
            FRESH();
            REP(PH_INIT) for (int t = gw; t < T; t += NGW) {
                const int b = t / TPB, j = t - b * TPB, mrow = j < CTXL ? 4 : b;
                const float* src = (l == 0) ? (j < CTXL ? args.in[I_CTX + zz] + ((size_t)b * CTXL + j) * DM : args.in[I_X + zz] + ((size_t)b * SEQ + (j - CTXL)) * DM) : H + (size_t)t * DM;
                const float* sh = mod_l + (size_t)mrow * 6 * DM; const float* sc = sh + DM;
#pragma unroll
                for (int i = 0; i < 8; ++i) { const int d = lane * 4 + 256 * i;
                    const f32x4 v = *(const f32x4*)(src + d), a = *(const f32x4*)(sh + d), s = *(const f32x4*)(sc + d);
                    const f32x4 y = v * (s + 1.0f) + a;
                    u32x2 w; w.x = pk2(y[0], y[1]); w.y = pk2(y[2], y[3]); *(u32x2*)(XM + (size_t)t * DM + d) = w; }
            }
            SEAM(sb + PH_INIT);
        }

        if (IN(sb + PH_WIN)) {
            FRESH();
            pg8::Gemm g{XM, WB + WE_IN, T, ZW, DM, DM, DM, 0, 0}; pg8::StaticOrder S; S.init(T, ZW, G, (int)blockIdx.x, 1, 1, 0, 4);
            pg8::EpiWin E{Z, GNB, KM, SSQ, SVS, TAB128, TAB64};
            REP(PH_WIN) pg8::gemm_phase<pg8::EpiWin, pg8::StaticOrder>((LAS unsigned char*)lds, g, S, E);
            SEAM(sb + PH_WIN);
        }

        if (IN(sb + PH_UP)) {
            FRESH();
            REP(PH_UP) {
            if ((int)blockIdx.x >= G - 64) {
                const bf16_t* Wkr = WB + WE_IN + (size_t)NKR * DM; const int l15 = lane & 15, l4 = lane >> 4;
                const int r0 = 64 * 256 + ((int)blockIdx.x - (G - 64)) * 16; const bf16_t* ap = XM + (size_t)(r0 + l15) * DM + wave * 256 + l4 * 8; const bf16_t* bp = Wkr + (size_t)l15 * DM + wave * 256 + l4 * 8;
                f32x4 acc[4] = {{0.f, 0.f, 0.f, 0.f}, {0.f, 0.f, 0.f, 0.f}, {0.f, 0.f, 0.f, 0.f}, {0.f, 0.f, 0.f, 0.f}};
#pragma unroll
                for (int kh = 0; kh < 2; ++kh) {
                    bf16x8 a[4], bb[4][4];
#pragma unroll
                    for (int k = 0; k < 4; ++k) { a[k] = *(const bf16x8*)(ap + (kh * 4 + k) * 32);
#pragma unroll
                        for (int nt = 0; nt < 4; ++nt) bb[k][nt] = *(const bf16x8*)(bp + (size_t)nt * 16 * DM + (kh * 4 + k) * 32); }
                    __builtin_amdgcn_sched_barrier(0);
#pragma unroll
                    for (int k = 0; k < 4; ++k)
#pragma unroll
                        for (int nt = 0; nt < 4; ++nt) acc[nt] = __builtin_amdgcn_mfma_f32_16x16x32_bf16(a[k], bb[k][nt], acc[nt], 0, 0, 0);
                    __builtin_amdgcn_sched_barrier(0);
                }
                LAS f32x4* red = (LAS f32x4*)lds;
#pragma unroll
                for (int nt = 0; nt < 4; ++nt) red[(wave * 4 + nt) * 64 + lane] = acc[nt];
                __syncthreads();
                if (wave == 0) {
#pragma unroll
                    for (int nt = 0; nt < 4; ++nt) { f32x4 s = red[nt * 64 + lane];
#pragma unroll
                        for (int w = 1; w < 8; ++w) s += red[(w * 4 + nt) * 64 + lane];
                        acc[nt] = s; }
#pragma unroll
                    for (int r = 0; r < 4; ++r) {
                        const int t = r0 + 4 * l4 + r, j = t - 3 * TPB, sidx = j - CTXL, prow = sidx >> 6, pcol = sidx & 63;
#pragma unroll
                        for (int nt = 0; nt < 4; ++nt) {
                            const float v = acc[nt][r], p = shflx(v, 1, lane);
                            const float2 cs = TAB64[((nt >> 1) ? pcol : prow) * 16 + 8 * (nt & 1) + (l15 >> 1)];
                            const float x1 = (l15 & 1) ? p : v, x2 = (l15 & 1) ? v : p;
                            const float o1 = x1 * cs.x - x2 * cs.y, o2 = x2 * cs.x + x1 * cs.y;
                            if (!(l15 & 1)) { const unsigned w = pk2(o1, o2);
#pragma unroll
                                for (int h = 0; h < 8; ++h) *(unsigned*)(KM + (size_t)t * 1536 + h * 192 + 128 + 16 * nt + l15) = w; }
                        }
                    }
                }
                __syncthreads();
            }
            { pg8::Gemm g{Z + NZQ, WB + WE_UQ, T, 3584, 512, ZS, 512, (size_t)(NZKV - NZQ) * 2, 0}; pg8::StaticOrder S; S.init(T, 3584, G, (int)blockIdx.x); S.pnsplit = 6;
              pg8::EpiUQKV E{pg8::EpiUQ{QM, SSQ, TAB64}, pg8::EpiUKV{KM, VM, SSQ}}; pg8::gemm_phase<pg8::EpiUQKV, pg8::StaticOrder>((LAS unsigned char*)lds, g, S, E); }
            {
                constexpr int LDP = 136, VSTR = 272;
                LAS bf16_t* Wl = (LAS bf16_t*)lds;
                LAS unsigned char* Vr = (LAS unsigned char*)lds + 128 * LDP * 2;
                LAS f32x2* St = (LAS f32x2*)(lds + 128 * LDP * 2 + 128 * VSTR);
                const float* sw = args.in[I_SW + zz] + (size_t)l * 8 * 128 * 128; const float* sbv = args.in[I_SB + zz] + (size_t)l * 8 * 128;
                const float* slg = args.in[I_SLNG + zz] + (size_t)l * 1024; const float* slb = args.in[I_SLNB + zz] + (size_t)l * 1024;
                bf16_t* YS = Y3 + (size_t)T * 1024;
                const int l15 = lane & 15, l4 = lane >> 4, p0 = wave * 16;
                const int vrb = (int)(uintptr_t)(lds + 128 * LDP * 2) + (l4 * 8 + (l15 >> 2)) * VSTR + (l15 & 3) * 8;
                REP(12) for (int unit = G - 1 - (int)blockIdx.x; unit < (T / 128) * 8; unit += G) {
                    const int gi = unit & 7, ch = unit >> 3, t0 = ch * 128;
                    __syncthreads();
                    if (tid < 128) { const float2* sp = SVS + (size_t)(t0 + tid) * 16; float s = 0.f, ss = 0.f;
#pragma unroll
                        for (int i = 0; i < 16; ++i) { const float2 p = sp[i]; s += p.x; ss += p.y; }
                        const float mean = s * (1.0f / 1024.0f), var = fmaxf(ss * (1.0f / 1024.0f) - mean * mean, 0.f);
                        St[tid] = (f32x2){mean, rsqrtf(var + EPS)}; }
                    f32x4 wv[8]; u32x4 zv[4];
#pragma unroll
                    for (int i = 0; i < 8; ++i) { const int idx = tid + 512 * i, p = idx >> 5, q4 = idx & 31; wv[i] = *(const f32x4*)(sw + ((size_t)gi * 128 + p) * 128 + q4 * 4); }
#pragma unroll
                    for (int i = 0; i < 4; ++i) { const int idx = tid + 512 * i, q = idx >> 4, c8 = idx & 15; zv[i] = *(const u32x4*)(Z + (size_t)(t0 + q) * ZS + NSV + gi * 128 + c8 * 8); }
                    const int c8 = tid & 15; const float* gp = slg + gi * 128 + c8 * 8; const float* bp = slb + gi * 128 + c8 * 8;
                    const f32x4 g0 = *(const f32x4*)gp, g1 = *(const f32x4*)(gp + 4), b0 = *(const f32x4*)bp, b1 = *(const f32x4*)(bp + 4);
                    __builtin_amdgcn_sched_barrier(0);
#pragma unroll
                    for (int i = 0; i < 8; ++i) { const int idx = tid + 512 * i, p = idx >> 5, q4 = idx & 31;
                        u32x2 o; o.x = pk2(wv[i][0], wv[i][1]); o.y = pk2(wv[i][2], wv[i][3]); *(LAS u32x2*)(Wl + p * LDP + q4 * 4) = o; }
                    __syncthreads();
#pragma unroll
                    for (int i = 0; i < 4; ++i) { const int idx = tid + 512 * i, q = idx >> 4;
                        float v[8]; unpack8(zv[i], v);
                        const f32x2 st = St[q];
                        float y[8];
#pragma unroll
                        for (int e = 0; e < 8; ++e) y[e] = (v[e] - st.x) * st.y * (e < 4 ? g0[e & 3] : g1[e & 3]) + (e < 4 ? b0[e & 3] : b1[e & 3]);
                        *(LAS u32x4*)(Vr + q * VSTR + c8 * 16) = pack8(y); }
                    __syncthreads();
                    bf16x8 bw[4];
#pragma unroll
                    for (int kk = 0; kk < 4; ++kk) bw[kk] = *(const LAS bf16x8*)(Wl + (p0 + l15) * LDP + kk * 32 + l4 * 8);
                    const int tok = t0 + p0 + l15; const float bsv = sbv[gi * 128 + p0 + l15];
                    u32x2 uus[8];
#pragma unroll
                    for (int cb = 0; cb < 8; ++cb) uus[cb] = *(const u32x2*)(Z + (size_t)tok * ZS + NSU + gi * 128 + cb * 16 + l4 * 4);
                    __builtin_amdgcn_sched_barrier(0);
#define SGU_CB(cb) do { \
                        const s16x4 a0l = att::tr_read<0 * 32 * VSTR + (cb) * 32>(vrb), a0h = att::tr_read<0 * 32 * VSTR + (cb) * 32 + 4 * VSTR>(vrb), a1l = att::tr_read<1 * 32 * VSTR + (cb) * 32>(vrb), a1h = att::tr_read<1 * 32 * VSTR + (cb) * 32 + 4 * VSTR>(vrb); \
                        const s16x4 a2l = att::tr_read<2 * 32 * VSTR + (cb) * 32>(vrb), a2h = att::tr_read<2 * 32 * VSTR + (cb) * 32 + 4 * VSTR>(vrb), a3l = att::tr_read<3 * 32 * VSTR + (cb) * 32>(vrb), a3h = att::tr_read<3 * 32 * VSTR + (cb) * 32 + 4 * VSTR>(vrb); \
                        asm volatile("s_waitcnt lgkmcnt(0)" ::: "memory"); __builtin_amdgcn_sched_barrier(0); \
                        f32x4 acc = {0.f, 0.f, 0.f, 0.f}; \
                        acc = __builtin_amdgcn_mfma_f32_16x16x32_bf16((bf16x8){a0l[0], a0l[1], a0l[2], a0l[3], a0h[0], a0h[1], a0h[2], a0h[3]}, bw[0], acc, 0, 0, 0); \
                        acc = __builtin_amdgcn_mfma_f32_16x16x32_bf16((bf16x8){a1l[0], a1l[1], a1l[2], a1l[3], a1h[0], a1h[1], a1h[2], a1h[3]}, bw[1], acc, 0, 0, 0); \
                        acc = __builtin_amdgcn_mfma_f32_16x16x32_bf16((bf16x8){a2l[0], a2l[1], a2l[2], a2l[3], a2h[0], a2h[1], a2h[2], a2h[3]}, bw[2], acc, 0, 0, 0); \
                        acc = __builtin_amdgcn_mfma_f32_16x16x32_bf16((bf16x8){a3l[0], a3l[1], a3l[2], a3l[3], a3h[0], a3h[1], a3h[2], a3h[3]}, bw[3], acc, 0, 0, 0); \
                        const int cc = gi * 128 + (cb) * 16 + l4 * 4; \
                        const u32x2 uu = uus[cb]; \
                        const float u0 = __uint_as_float(uu.x << 16), u1 = __uint_as_float(uu.x & 0xffff0000u), u2 = __uint_as_float(uu.y << 16), u3 = __uint_as_float(uu.y & 0xffff0000u); \
                        u32x2 o; o.x = pk2(u0 * (acc[0] + bsv), u1 * (acc[1] + bsv)); o.y = pk2(u2 * (acc[2] + bsv), u3 * (acc[3] + bsv)); \
                        *(u32x2*)(YS + (size_t)tok * 1024 + cc) = o; } while (0)
                    SGU_CB(0); SGU_CB(1); SGU_CB(2); SGU_CB(3); SGU_CB(4); SGU_CB(5); SGU_CB(6); SGU_CB(7);
#undef SGU_CB
                }
                __syncthreads();
            }
            }
            SEAM(sb + PH_UP);
        }

        if (IN(sb + PH_ATTN)) {
            FRESH();
            constexpr int NBIG_M = 512, NSM_M = 32;
            bf16_t* YA = Y3;
#ifndef ATT_SEL
#define ATT_SEL 3
#endif
            REP(PH_ATTN) {
            if (ATT_SEL & 1)
            for (int uidx = blockIdx.x; uidx < NBIG_M + (l == DEPTH - 1 ? 0 : 64 + NSM_M); uidx += G) {
                __syncthreads();
                int bh, qb; bool small;
                if (uidx < NBIG_M) { const int c = uidx & 255, i = uidx >> 8; bh = (c & 7) * 2 + ((c >> 3) >> 4) + 16 * i; qb = (c >> 3) & 15; small = false; }
                else { bh = uidx - NBIG_M - 64; qb = 0; small = true; if (bh < 0) continue; }
                const int b = bh >> 3, h = bh & 7; const size_t tk0 = (size_t)b * TPB, tq0 = tk0 + (small ? 0 : CTXL + qb * 256);
                att::attn_body16<192, 128, 1536, 1536, 1024, 1024, bf16_t, false, false, false>(QM + tq0 * 1536 + h * 192, KM + tk0 * 1536 + h * 192, VM + tk0 * 1024 + h * 128,
                                                                            YA + tq0 * 1024 + h * 128, small ? CTXL : TPB, (char*)lds);
            }
            if (ATT_SEL & 2)
            for (int uidx = blockIdx.x; uidx < 512 + (l == DEPTH - 1 ? 0 : 32); uidx += G) {
                __syncthreads();
                int combo, qb; bool small;
                if (uidx < 512) { const int c = uidx & 255, i = uidx >> 8; combo = (c & 7) * 2 + ((c >> 3) >> 4) + 16 * i; qb = (c >> 3) & 15; small = false; }
                else { combo = uidx - 512; qb = 0; small = true; }
                const int mp = combo & 1, h = (combo >> 1) & 3, b = combo >> 3;
                const size_t tk0 = (size_t)b * TPB, tq0 = tk0 + (small ? 0 : CTXL + qb * 256);
                att::attn_body16<128, 256, ZS, ZS, ZS, 1024, float, false, true, true>(Z + tq0 * ZS + NDQ + h * 256 + mp * 128, Z + tk0 * ZS + NDK + h * 256 + mp * 128, Z + tk0 * ZS + NDV + h * 256,
                                                                                          OD + (size_t)mp * T * 1024 + tq0 * 1024 + h * 256, small ? CTXL : TPB, (char*)lds);
            }
            }
            __syncthreads();
            SEAM(sb + PH_ATTN);
        }

        if (IN(sb + PH_DIFFC)) {
            FRESH();
            const float lam = LAM[l], omli = 1.0f - LAM[4 + l]; const float* sub = args.in[I_DSUB + zz] + (size_t)l * 256;
            bf16_t* YD = Y3 + (size_t)2 * T * 1024;
            f32x4 gsub[4];
#pragma unroll
            for (int i = 0; i < 4; ++i) gsub[i] = *(const f32x4*)(sub + (lane & 15) * 4 + 64 * i) * omli;
            REP(PH_DIFFC) for (int t = gw; t < T; t += NGW) {
                const int h = lane >> 4, c0 = (lane & 15) * 4;
                const float* o1 = OD + (size_t)t * 1024 + h * 256; const float* o2 = o1 + (size_t)T * 1024;
                f32x4 d[4], e2[4]; float ss = 0.f;
#pragma unroll
                for (int i = 0; i < 4; ++i) { d[i] = *(const f32x4*)(o1 + c0 + 64 * i); e2[i] = *(const f32x4*)(o2 + c0 + 64 * i); }
                __builtin_amdgcn_sched_barrier(0);
#pragma unroll
                for (int i = 0; i < 4; ++i) { d[i] = d[i] - e2[i] * lam; ss += d[i][0] * d[i][0] + d[i][1] * d[i][1] + d[i][2] * d[i][2] + d[i][3] * d[i][3]; }
                ss += shflx(ss, 1, lane); ss += shflx(ss, 2, lane); ss += shflx(ss, 4, lane); ss += shflx(ss, 8, lane);
                const float rstd = rsqrtf(ss * (1.0f / 256.0f) + EPS);
#pragma unroll
                for (int i = 0; i < 4; ++i) { const f32x4 y = d[i] * rstd * gsub[i];
                    u32x2 w; w.x = pk2(y[0], y[1]); w.y = pk2(y[2], y[3]); *(u32x2*)(YD + (size_t)t * 1024 + h * 256 + c0 + 64 * i) = w; }
            }
            SEAM(sb + PH_DIFFC);
        }

        if (IN(sb + PH_MERGE)) {
            FRESH();
            pg8::Gemm g{Y3, WB + WE_BR, T, DM, 1024, 1024, 1024, (size_t)T * 1024 * 2, (size_t)DM * 1024 * 2}; pg8::StaticOrder S; S.init(T, DM, G, (int)blockIdx.x, 3, DUPF(PH_MERGE), l == DEPTH - 1);
            if (l < DEPTH - 1 && DUPF(PH_MERGE) == 1 && 512 % G == 0) { S.tailM = 1; S.nM = 64; S.nwg = 512; }
            pg8::EpiMerge E{GNB, MRG, PART, (unsigned*)(ws + WS_CTL) + 65536 + l * 256};
            pg8::gemm_phase<pg8::EpiMerge, pg8::StaticOrder>((LAS unsigned char*)lds, g, S, E);
            SEAM(sb + PH_MERGE);
        }

        if (IN(sb + PH_OUT)) {
            FRESH();
            pg8::Gemm g{MRG, WB + WE_OUT, T, DM, DM, LDM, DM, (size_t)(DM / 8) * 2, (size_t)(DM / 8) * 2}; pg8::StaticOrder S; S.init(T, DM, G, (int)blockIdx.x, 1, DUPF(PH_OUT), l == DEPTH - 1);
            if (l < DEPTH - 1) { S.tailS = 8; S.tailnt = DM / 8 / 64; S.nM = 64; S.nwg = 512; }
            pg8::EpiBf16 E{MIX, LDM, PART};
            pg8::gemm_phase<pg8::EpiBf16, pg8::StaticOrder>((LAS unsigned char*)lds, g, S, E);
            SEAM(sb + PH_OUT);
        }

        if (IN(sb + PH_LN1)) {
            FRESH();
            ln_phase<0>(args, l, mod_l, H, MIX, PART, XM, lane, gw, NGW);
            SEAM(sb + PH_LN1);
        }
        if (IN(sb + PH_GU)) {
            FRESH();
            pg8::Gemm g{XM, WB + WE_GU, T, 2 * FF, DM, DM, DM, 0, 0}; pg8::StaticOrder S; S.init(T, 2 * FF, G, (int)blockIdx.x, 1, 1, l == DEPTH - 1);
            pg8::EpiSwiGlu E{HH};
            REP(PH_GU) pg8::gemm_phase<pg8::EpiSwiGlu, pg8::StaticOrder>((LAS unsigned char*)lds, g, S, E);
            SEAM(sb + PH_GU);
        }
        if (IN(sb + PH_DOWN)) {
            FRESH();
            pg8::Gemm g{HH, WB + WE_DN, T, DM, FF, FF, FF, (size_t)(FF / 4) * 2, (size_t)(FF / 4) * 2}; pg8::StaticOrder S; S.init(T, DM, G, (int)blockIdx.x, 1, DUPF(PH_DOWN), l == DEPTH - 1);
            if (l < DEPTH - 1) { S.tailS = 4; S.tailnt = FF / 4 / 64; S.nM = 64; S.nwg = 512; }
            pg8::EpiBf16 E{MIX, LDM, PART};
            pg8::gemm_phase<pg8::EpiBf16, pg8::StaticOrder>((LAS unsigned char*)lds, g, S, E);
            SEAM(sb + PH_DOWN);
        }
        if (IN(sb + PH_LN2)) {
            FRESH();
            ln_phase<1>(args, l, mod_l, H, MIX, PART, XM, lane, gw, NGW);
        }
    }
#undef IN
#undef SEAM
}

extern "C" void kernel_launch(void* const* d_in, const int* in_sizes, int n_in, void* d_out, int out_size, void* d_ws, size_t ws_size, hipStream_t stream) {
    static int grid = 0;
    if (grid == 0) {
        if (n_in != 25 || out_size != NBATCH * SEQ * DM || ws_size < WS_END) { fprintf(stderr, "kernel_launch: unexpected shapes (n_in %d out %d ws %zu, need ws >= %zu); nothing launched\n", n_in, out_size, ws_size, (size_t)WS_END); grid = -1; return; }
        int dev = 0, cus = 0, per_cu = 0;
        if (hipGetDevice(&dev) != hipSuccess || hipDeviceGetAttribute(&cus, hipDeviceAttributeMultiprocessorCount, dev) != hipSuccess) { grid = -1; return; }
        if (hipFuncSetAttribute((const void*)mk_fwd, hipFuncAttributeMaxDynamicSharedMemorySize, LDS_BYTES) != hipSuccess) { fprintf(stderr, "kernel_launch: hipFuncSetAttribute failed\n"); grid = -1; return; }
        if (hipOccupancyMaxActiveBlocksPerMultiprocessor(&per_cu, (const void*)mk_fwd, 512, LDS_BYTES) != hipSuccess || per_cu < 1) { fprintf(stderr, "kernel_launch: occupancy query says %d\n", per_cu); }
        (void)hipGetLastError();
        grid = cus;
    }
    if (grid < 0) return;
    (void)hipMemsetAsync((char*)d_ws + WS_CTL, 0, CTL_BYTES, stream);
    Args a{};
    for (int i = 0; i < 25; ++i) a.in[i] = (const float*)d_in[i];
    a.in[I_OUT_] = (const float*)d_out; a.in[I_WS_] = (const float*)d_ws;
#if MK_PER_PHASE
    for (int s = 0; s < DEPTH * NPH; ++s) { a.s_lo = s; a.s_hi = s + 1; hipLaunchKernelGGL(mk_fwd, dim3(grid), dim3(512), LDS_BYTES, stream, a); }
#else
    a.s_lo = 0; a.s_hi = DEPTH * NPH; hipLaunchKernelGGL(mk_fwd, dim3(grid), dim3(512), LDS_BYTES, stream, a);
#endif
    const hipError_t le = hipPeekAtLastError();
    if (le != hipSuccess) fprintf(stderr, "kernel_launch: launch failed: %s\n", hipGetErrorName(le));
}
```

```cpp
#include <hip/hip_runtime.h>
#include <cstdio>
#include <cstdint>

#ifndef MK_PER_PHASE
#define MK_PER_PHASE 0
#define PROBE_DUP 0
#endif

#define LAS __attribute__((address_space(3)))
typedef unsigned short bf16_t;
typedef short bf16x8 __attribute__((ext_vector_type(8)));
typedef short s16x4 __attribute__((ext_vector_type(4)));
typedef float f32x4 __attribute__((ext_vector_type(4)));
typedef float f32x16 __attribute__((ext_vector_type(16)));
typedef float f32x2 __attribute__((ext_vector_type(2)));
typedef unsigned u32x4 __attribute__((ext_vector_type(4)));
typedef unsigned u32x2 __attribute__((ext_vector_type(2)));

constexpr int DM = 2048, NBATCH = 4, SEQ = 4096, CTXL = 256, DEPTH = 4;
constexpr int TPB = CTXL + SEQ;
constexpr int T = NBATCH * TPB;
constexpr int INW = 12352, ZW = 12544;
constexpr int ZS = 6208;
constexpr int NZQ = 0, NZKV = 512, NSU = 1024, NSV = 2048, NDQ = 3072, NDK = 4096, NDV = 5120, NG = 6144, NKR = 12288;
constexpr int FF = 5632;
constexpr int LDM = DM + 64;
constexpr float ALPHA = 1.681792830507429f;
constexpr float EPS = 1e-5f;
constexpr int NPH = 12;
enum { PH_CONV = 0, PH_INIT, PH_WIN, PH_UP, PH_ATTN, PH_DIFFC, PH_MERGE, PH_OUT, PH_LN1, PH_GU, PH_DOWN, PH_LN2 };

constexpr size_t WS_CTL = 0, CTL_BYTES = 1u << 20;
constexpr size_t WS_MOD = WS_CTL + CTL_BYTES;
constexpr size_t MOD_BYTES = (size_t)DEPTH * 5 * 6 * DM * 4;
constexpr size_t WS_MISC = WS_MOD + MOD_BYTES;
constexpr size_t MISC_BYTES = 65536;
constexpr size_t WS_WB = WS_MISC + MISC_BYTES;
constexpr size_t WE_IN = 0, WE_UQ = WE_IN + (size_t)ZW * DM, WE_UKV = WE_UQ + (size_t)1536 * 512, WE_BR = WE_UKV + (size_t)2048 * 512,
                 WE_OUT = WE_BR + (size_t)3 * DM * 1024, WE_GU = WE_OUT + (size_t)DM * DM, WE_DN = WE_GU + (size_t)2 * FF * DM, WE_END = WE_DN + (size_t)DM * FF;
constexpr size_t WS_H = WS_WB + WE_END * 2;
constexpr size_t WS_XM = WS_H + (size_t)T * DM * 4;
constexpr size_t WS_Z = WS_XM + (size_t)T * DM * 2;
constexpr size_t WS_GN = WS_Z + (size_t)T * ZS * 2;
constexpr size_t WS_B = WS_GN + (size_t)(T / 256) * 24 * 131072;
constexpr size_t B_QM = 0, B_KM = B_QM + (size_t)T * 1536 * 2, B_VM = B_KM + (size_t)T * 1536 * 2, B_Y3 = B_VM + (size_t)T * 1024 * 2,
                 B_OD = B_Y3 + (size_t)3 * T * 1024 * 2, B_SSQ = B_OD + (size_t)2 * T * 1024 * 4, B_SVS = B_SSQ + (size_t)T * 16 * 4, B_END = B_SVS + (size_t)T * 16 * 8;
constexpr size_t WS_MRG = WS_B + B_END;
constexpr size_t WS_MIX = WS_MRG + (size_t)T * LDM * 2;
constexpr size_t WS_PART = WS_MIX + (size_t)T * LDM * 2;
constexpr size_t WS_END = WS_PART + (size_t)8 * 1024 * LDM * 2;
static_assert((size_t)T * FF * 2 <= B_END, "overlays");
static_assert(WS_END <= 1619001344ull, "workspace budget (4 x largest tensor)");
static_assert(WS_WB % 256 == 0 && WS_H % 256 == 0 && WS_Z % 256 == 0 && WS_B % 256 == 0 && B_OD % 256 == 0 && B_SSQ % 256 == 0 && B_SVS % 256 == 0, "alignment");

constexpr int LDS_RING = 131072, LDS_BYTES = 147456, LDS_MISC = LDS_BYTES - 256;

__device__ __forceinline__ float bf2f(unsigned short b) { return __uint_as_float(((unsigned)b) << 16); }
__device__ __forceinline__ unsigned f2bf(float f) { unsigned u = __float_as_uint(f); return (u + 0x7fffu + ((u >> 16) & 1u)) >> 16; }
typedef __bf16 bf16x2_g __attribute__((ext_vector_type(2)));
typedef float f32x2_g __attribute__((ext_vector_type(2)));
__device__ __forceinline__ unsigned pk2(float lo, float hi) { const f32x2_g v = {lo, hi}; return __builtin_bit_cast(unsigned, __builtin_convertvector(v, bf16x2_g)); }
__device__ __forceinline__ void unpack8(u32x4 w, float (&f)[8]) {
    f[0] = __uint_as_float(w.x << 16); f[1] = __uint_as_float(w.x & 0xffff0000u); f[2] = __uint_as_float(w.y << 16); f[3] = __uint_as_float(w.y & 0xffff0000u);
    f[4] = __uint_as_float(w.z << 16); f[5] = __uint_as_float(w.z & 0xffff0000u); f[6] = __uint_as_float(w.w << 16); f[7] = __uint_as_float(w.w & 0xffff0000u);
}
__device__ __forceinline__ u32x4 pack8(const float (&f)[8]) { u32x4 w; w.x = pk2(f[0], f[1]); w.y = pk2(f[2], f[3]); w.z = pk2(f[4], f[5]); w.w = pk2(f[6], f[7]); return w; }
__device__ __forceinline__ float shflx(float v, int mask, int lane) { return __int_as_float(__builtin_amdgcn_ds_bpermute((lane ^ mask) << 2, __float_as_int(v))); }
__device__ __forceinline__ float wave_sum(float v, int lane) {
#pragma unroll
    for (int o = 1; o < 64; o <<= 1) v += shflx(v, o, lane);
    return v;
}
__device__ __forceinline__ float sigmoidf_(float x) { return __builtin_amdgcn_rcpf(1.0f + __builtin_amdgcn_exp2f(-1.4426950408889634f * x)); }
__device__ __forceinline__ float gelu_tanh(float x) { const float u = 0.7978845608028654f * (x + 0.044715f * x * x * x); const float t = 1.0f - 2.0f * __builtin_amdgcn_rcpf(1.0f + __builtin_amdgcn_exp2f(2.8853900817779268f * u)); return 0.5f * x * (1.0f + t); }

__device__ __forceinline__ int fresh_zero() { int z = 0; asm volatile("" : "+s"(z)); return z; }
__device__ __forceinline__ unsigned char* fresh_ptr(unsigned char* p) {
    unsigned lo = __builtin_amdgcn_readfirstlane((unsigned)(uintptr_t)p), hi = __builtin_amdgcn_readfirstlane((unsigned)((uintptr_t)p >> 32));
    asm volatile("" : "+s"(lo), "+s"(hi));
    return (unsigned char*)(((uintptr_t)hi << 32) | (uintptr_t)lo);
}
__device__ __forceinline__ int fresh_tid() { int t = threadIdx.x; asm volatile("" : "+v"(t)); return t; }

#define XB_TMO      128
#define XB_XCNT(j)  (256  + 64 * (j))
#define XB_XSUB(j)  (1280 + 64 * (j))
#define XB_XGEN(j)  (2304 + 64 * (j))
#define XB_TOP      3328
#define XB_TOPGEN   3392
#define XCD_BAR_WORDS 3456
#define XB_SPIN_CAP (1u << 18)
__device__ __forceinline__ unsigned xb_ld(unsigned* p)              { return __hip_atomic_load(p, __ATOMIC_RELAXED, __HIP_MEMORY_SCOPE_AGENT); }
__device__ __forceinline__ unsigned xb_add(unsigned* p, unsigned v) { return __hip_atomic_fetch_add(p, v, __ATOMIC_RELAXED, __HIP_MEMORY_SCOPE_AGENT); }
__device__ __forceinline__ unsigned xb_xcc_id() { return (unsigned)__builtin_amdgcn_s_getreg((3 << 11) | 20) & 0xFu; }
#define XB_SPIN(cond, bar) do { unsigned _sp = 0; while (cond) { __builtin_amdgcn_s_sleep(1); \
    if ((++_sp & 255u) == 0u) { if (xb_ld(&(bar)[XB_TMO])) break; if (_sp > XB_SPIN_CAP) { atomicAdd(&(bar)[XB_TMO], 1u); break; } } } } while (0)
struct XcdBarrier { unsigned* bar; unsigned x; volatile LAS unsigned* st; };
__device__ __forceinline__ XcdBarrier xcd_barrier_post(unsigned* bar, volatile LAS unsigned* st) {
    XcdBarrier b; b.bar = bar; b.x = xb_xcc_id(); b.st = st;
    if (threadIdx.x == 0) (void)xb_add(&bar[XB_XCNT(b.x)], 1u);
    return b;
}
__device__ __forceinline__ void xcd_barrier_complete(unsigned* bar, unsigned x, unsigned& nloc, unsigned& nx) {
    const unsigned G = gridDim.x * gridDim.y * gridDim.z;
    unsigned sum, cnt, mine, sp = 0u;
    for (;;) {
        sum = 0u; cnt = 0u; mine = 0u;
#pragma unroll
        for (unsigned j = 0; j < 16; ++j) { const unsigned c = xb_ld(&bar[XB_XCNT(j)]); sum += c; cnt += (c > 0u) ? 1u : 0u; mine = (j == x) ? c : mine; }
        if (sum == G) break;
        __builtin_amdgcn_s_sleep(1);
        if ((++sp & 255u) == 0u) { if (xb_ld(&bar[XB_TMO])) break; if (sp > XB_SPIN_CAP) { atomicAdd(&bar[XB_TMO], 1u); break; } }
    }
    nloc = mine > 0u ? mine : 1u; nx = cnt > 0u ? cnt : 1u;
}
__device__ __forceinline__ void xcd_barrier(const XcdBarrier& b) {
    asm volatile("s_waitcnt vmcnt(0)" ::: "memory");
    __syncthreads();
    if (threadIdx.x == 0) {
        unsigned* bar = b.bar;
        __builtin_amdgcn_s_waitcnt(0);
        unsigned nloc = b.st[0], nx = b.st[1];
        if (nloc == 0u) { xcd_barrier_complete(bar, b.x, nloc, nx); b.st[0] = nloc; b.st[1] = nx; }
        const unsigned old = xb_add(&bar[XB_XSUB(b.x)], 1u);
        const unsigned gen = old / nloc;
        if (old + 1u == (gen + 1u) * nloc) {
            __builtin_amdgcn_fence(__ATOMIC_RELEASE, "agent");
            asm volatile("s_waitcnt vmcnt(0)" ::: "memory");
            const unsigned og = xb_add(&bar[XB_TOP], 1u);
            const unsigned tg = og / nx;
            if (og + 1u == (tg + 1u) * nx) xb_add(&bar[XB_TOPGEN], 1u);
            else XB_SPIN(xb_ld(&bar[XB_TOPGEN]) == tg, bar);
            __builtin_amdgcn_fence(__ATOMIC_ACQUIRE, "agent");
            xb_add(&bar[XB_XGEN(b.x)], 1u);
            asm volatile("s_waitcnt vmcnt(0)" ::: "memory");
        } else {
            XB_SPIN(xb_ld(&bar[XB_XGEN(b.x)]) == gen, bar);
            __builtin_amdgcn_fence(__ATOMIC_ACQUIRE, "agent");
            asm volatile("s_waitcnt vmcnt(0)" ::: "memory");
        }
    }
    __syncthreads();
}

namespace pg8 {
constexpr int BM = 256, BK = 64, HALF = 128, HTB = HALF * BK * 2, STAGE_BYTES = 8 * HTB, NXCD = 8, WGM = 4;
__host__ __device__ __forceinline__ int lds_byte(int r, int c) { const int st = (r >> 4) * 2 + (c >> 5), rr = r & 15, cc = c & 31, ob = rr * 64 + cc * 2; return st * 1024 + (ob ^ (((ob >> 9) & 1) << 5)); }
__host__ __device__ __forceinline__ void stage_rc(int b, int& R, int& C) { const int st = b / 1024, sb = b % 1024, swz = sb ^ (((sb >> 9) & 1) << 5); R = (st >> 1) * 16 + swz / 64; C = (st & 1) * 32 + (swz % 64) / 2; }
__host__ __device__ __forceinline__ int perm32(int rho) { const int n = rho >> 4, i = rho & 15; return 8 * (i >> 2) + 4 * n + (i & 3); }

struct Unit { int pm, pn, seg, nt; };
struct Gemm { const bf16_t* A; const bf16_t* Bt; int M, N, K, lda, ldb; size_t segA, segB; };

struct StaticOrder {
    int tailS = 0, tailnt = 0;
    int tailM = 0;
    int wgm = WGM;
    int nM, nN, nwg, G, c, nseg, dup, latonly, pnsplit = 0;
    __device__ void init(int M, int N, int G_, int c_, int nseg_ = 1, int dup_ = 1, int latonly_ = 0, int drop_ = 0) { nM = latonly_ ? 64 : M / BM; nN = N / BM; nwg = nM * nN - drop_; G = G_; c = c_; nseg = nseg_; dup = dup_; latonly = latonly_; }
    __device__ bool next(int i, Unit& u) const {
        const int per = nseg * dup, ti = i / per; u.seg = (i - ti * per) % nseg; u.nt = 0;
        if (tailM) { const int i0 = per * (512 / G); if (i >= i0) { const int idx = c + G * (i - i0); if (idx >= 96) return false; const int tile = idx / 3; u.pm = 64 + (tile >> 3); u.pn = tile & 7; u.seg = idx - tile * 3; u.nt = 16; return true; } }
        if (tailS) { const long Lt = (long)ti * G + c;
            if (Lt >= 512) { const int idx = (int)(Lt - 512); if (idx >= 32 * tailS) return false; const int tile = idx / tailS; u.pm = 64 + (tile >> 3); u.pn = tile & 7; u.seg = idx - tile * tailS; u.nt = tailnt; return true; } }
        const long L = (long)ti * G + c; if (L >= nwg) return false;
        int wgid = (int)L; { const int q = nwg / NXCD, r = nwg % NXCD, xcd = wgid % NXCD, off = wgid / NXCD; wgid = (xcd < r ? xcd * (q + 1) : r * (q + 1) + (xcd - r) * q) + off; }
        const int nig = wgm * nN, gid = wgid / nig, fm = gid * wgm, gsz = (nM - fm) < wgm ? (nM - fm) : wgm;
        u.pm = fm + ((wgid % nig) % gsz); u.pn = (wgid % nig) / gsz; if (latonly) u.pm = (u.pm >> 4) * 17 + 1 + (u.pm & 15); if (pnsplit) u.seg = u.pn >= pnsplit; return true;
    }
    __device__ __forceinline__ void a_ready(const Unit&) const {}
    __device__ __forceinline__ void done(const Unit&) const {}
};

typedef __bf16 bf16x2_t __attribute__((ext_vector_type(2)));
typedef float f32x2_t __attribute__((ext_vector_type(2)));
__device__ __forceinline__ unsigned cvt_pk_bf16(float lo, float hi) { const f32x2_t v = {lo, hi}; return __builtin_bit_cast(unsigned, __builtin_convertvector(v, bf16x2_t)); }

struct EpiBf16 {
    __device__ __forceinline__ void prefetch(const Unit&, LAS unsigned char*, int) const {}
    static constexpr int ID = 1; static constexpr bool IDEMP = true; static constexpr bool PERM = true;
    bf16_t* O; int ldc; bf16_t* P = nullptr;
    __device__ __forceinline__ bool keep(const Unit&) const { return false; }
    __device__ __forceinline__ void operator()(f32x4 (&acc)[2][2][4][2], const Unit& u, int wr, int wc, int fr, int fq) const {
        const int row0 = u.pm * BM + wr * 64 + fr, col0 = u.pn * BM + wc * 32 + 8 * fq;
        bf16_t* ob = u.nt ? P + ((size_t)u.seg * 1024 - 16384) * ldc : O;
#pragma unroll
        for (int ai = 0; ai < 2; ++ai)
#pragma unroll
            for (int m = 0; m < 4; ++m) { bf16_t* rowp = ob + (size_t)(row0 + ai * HALF + m * 16) * ldc + col0;
#pragma unroll
                for (int bj = 0; bj < 2; ++bj) { const f32x4 v0 = acc[ai][bj][m][0], v1 = acc[ai][bj][m][1];
                    u32x4 w; w.x = cvt_pk_bf16(v0[0], v0[1]); w.y = cvt_pk_bf16(v0[2], v0[3]); w.z = cvt_pk_bf16(v1[0], v1[1]); w.w = cvt_pk_bf16(v1[2], v1[3]);
                    *(u32x4*)(rowp + bj * HALF) = w; } }
    }
};
struct EpiWin {
    __device__ __forceinline__ void prefetch(const Unit&, LAS unsigned char*, int) const {}
    static constexpr int ID = 2; static constexpr bool IDEMP = true; static constexpr bool PERM = true;
    bf16_t* Z; bf16_t* GN; bf16_t* KM; float* SSQ; float2* SVS; const float2* T128; const float2* T64;
    __device__ __forceinline__ bool keep(const Unit&) const { return false; }
    __device__ __forceinline__ void st8(bf16_t* p, const float (&v)[8]) const { u32x4 w; w.x = cvt_pk_bf16(v[0], v[1]); w.y = cvt_pk_bf16(v[2], v[3]); w.z = cvt_pk_bf16(v[4], v[5]); w.w = cvt_pk_bf16(v[6], v[7]); *(u32x4*)p = w; }
    __device__ __forceinline__ void operator()(f32x4 (&acc)[2][2][4][2], const Unit& u, int wr, int wc, int fr, int fq) const {
        const int pn = u.pn, lane = fq * 16 + fr, pmb = u.pm % 17; const bool lat = pmb != 0;
        const int row0 = u.pm * BM + wr * 64 + fr, colq = wc * 32 + 8 * fq;
        bf16_t* zp = Z + (size_t)row0 * ZS + pn * BM + colq;
#define EW_ROWS for (int ai = 0; ai < 2; ++ai) _Pragma("unroll") for (int m = 0; m < 4; ++m)
#define EW_V(bj, e) acc[ai][bj][m][(e) >> 2][(e) & 3]
#define EW_ZP(bj) (zp + (size_t)(ai * HALF + m * 16) * ZS + (bj) * HALF)
        if (pn < 4) {
#pragma unroll
            EW_ROWS { float ss = 0.f;
#pragma unroll
                for (int bj = 0; bj < 2; ++bj) { float v[8];
#pragma unroll
                    for (int e = 0; e < 8; ++e) { v[e] = EW_V(bj, e); ss += v[e] * v[e]; }
                    st8(EW_ZP(bj), v); }
                ss += shflx(ss, 16, lane); ss += shflx(ss, 32, lane);
                if (fq == 0) SSQ[(size_t)(row0 + ai * HALF + m * 16) * 16 + pn * 4 + wc] = ss; }
        } else if (pn < 8) {
#pragma unroll
            EW_ROWS {
#pragma unroll
                for (int bj = 0; bj < 2; ++bj) { float v[8];
#pragma unroll
                    for (int e = 0; e < 8; ++e) v[e] = gelu_tanh(EW_V(bj, e));
                    st8(EW_ZP(bj), v); } }
        } else if (pn < 12) {
#pragma unroll
            EW_ROWS { float s = 0.f, ss = 0.f;
#pragma unroll
                for (int bj = 0; bj < 2; ++bj) { float v[8];
#pragma unroll
                    for (int e = 0; e < 8; ++e) { const float g = gelu_tanh(EW_V(bj, e)); v[e] = g; s += g; ss += g * g; }
                    st8(EW_ZP(bj), v); }
                s += shflx(s, 16, lane); s += shflx(s, 32, lane); ss += shflx(ss, 16, lane); ss += shflx(ss, 32, lane);
                if (fq == 0) SVS[(size_t)(row0 + ai * HALF + m * 16) * 16 + (pn - 8) * 4 + wc] = make_float2(s, ss); }
        } else if (pn < 20 && lat) {
#pragma unroll
            for (int ai = 0; ai < 2; ++ai) { f32x4 c01[4], c23[4];
#pragma unroll
                for (int m = 0; m < 4; ++m) { const int prow = (pmb - 1) * 4 + 2 * ai + wr, pcol = 16 * m + fr;
                    const float2* tp = T128 + ((wc >> 1) ? pcol : prow) * 32 + 16 * (wc & 1) + 4 * fq; c01[m] = *(const f32x4*)tp; c23[m] = *(const f32x4*)(tp + 2); }
                __builtin_amdgcn_sched_barrier(0);
#pragma unroll
                for (int m = 0; m < 4; ++m) {
                    const float cs[4] = {c01[m][0], c01[m][2], c23[m][0], c23[m][2]}, sn[4] = {c01[m][1], c01[m][3], c23[m][1], c23[m][3]};
#pragma unroll
                    for (int bj = 0; bj < 2; ++bj) { float v[8];
#pragma unroll
                        for (int p = 0; p < 4; ++p) { const float x1 = EW_V(bj, 2 * p), x2 = EW_V(bj, 2 * p + 1); v[2 * p] = x1 * cs[p] - x2 * sn[p]; v[2 * p + 1] = x2 * cs[p] + x1 * sn[p]; }
                        st8(EW_ZP(bj), v); } } }
        } else if (pn < 24) {
#pragma unroll
            EW_ROWS {
#pragma unroll
                for (int bj = 0; bj < 2; ++bj) { float v[8];
#pragma unroll
                    for (int e = 0; e < 8; ++e) v[e] = EW_V(bj, e);
                    st8(EW_ZP(bj), v); } }
        } else if (pn < 48) {
            bf16_t* gt = GN + ((size_t)u.pm * 24 + (pn - 24)) * 65536 + ((size_t)(wr * 4 + wc) * 16 * 64 + lane) * 8;
#pragma unroll
            EW_ROWS {
#pragma unroll
                for (int bj = 0; bj < 2; ++bj) { float v[8];
#pragma unroll
                    for (int e = 0; e < 8; ++e) v[e] = sigmoidf_(EW_V(bj, e));
                    st8(gt + ((ai * 4 + m) * 2 + bj) * 512, v); } }
        } else if (wc < 2) {
#pragma unroll
            EW_ROWS { const int prow = (pmb - 1) * 4 + 2 * ai + wr, pcol = 16 * m + fr; float v[8];
#pragma unroll
                for (int e = 0; e < 8; ++e) v[e] = EW_V(0, e);
                if (lat) { const float2* tp = T64 + (wc ? pcol : prow) * 16 + 4 * fq; const f32x4 c01 = *(const f32x4*)tp, c23 = *(const f32x4*)(tp + 2);
                    const float cs[4] = {c01[0], c01[2], c23[0], c23[2]}, sn[4] = {c01[1], c01[3], c23[1], c23[3]};
#pragma unroll
                    for (int p = 0; p < 4; ++p) { const float x1 = v[2 * p], x2 = v[2 * p + 1]; v[2 * p] = x1 * cs[p] - x2 * sn[p]; v[2 * p + 1] = x2 * cs[p] + x1 * sn[p]; } }
                u32x4 w; w.x = cvt_pk_bf16(v[0], v[1]); w.y = cvt_pk_bf16(v[2], v[3]); w.z = cvt_pk_bf16(v[4], v[5]); w.w = cvt_pk_bf16(v[6], v[7]);
#pragma unroll
                for (int h = 0; h < 8; ++h) *(u32x4*)(KM + (size_t)(row0 + ai * HALF + m * 16) * 1536 + h * 192 + 128 + colq) = w; }
        }
#undef EW_ROWS
#undef EW_V
#undef EW_ZP
    }
};
struct EpiUQ {
    __device__ __forceinline__ void prefetch(const Unit&, LAS unsigned char*, int) const {}
    static constexpr int ID = 3; static constexpr bool IDEMP = true; static constexpr bool PERM = true;
    bf16_t* QM; const float* SSQ; const float2* T64;
    __device__ __forceinline__ bool keep(const Unit&) const { return false; }
    __device__ __forceinline__ void operator()(f32x4 (&acc)[2][2][4][2], const Unit& u, int wr, int wc, int fr, int fq) const {
        const int pmb = u.pm % 17; const bool lat = pmb != 0;
        const int row0 = u.pm * BM + wr * 64 + fr;
#pragma unroll
        for (int ai = 0; ai < 2; ++ai) {
            f32x4 s0[4], s1[4]; float rstd[4];
#pragma unroll
            for (int m = 0; m < 4; ++m) { const float* sp = SSQ + (size_t)(row0 + ai * HALF + m * 16) * 16; s0[m] = *(const f32x4*)sp; s1[m] = *(const f32x4*)(sp + 4); }
#pragma unroll
            for (int m = 0; m < 4; ++m) rstd[m] = rsqrtf(((s0[m][0] + s0[m][1]) + (s0[m][2] + s0[m][3]) + (s1[m][0] + s1[m][1]) + (s1[m][2] + s1[m][3])) * (1.0f / 512.0f) + EPS);
#pragma unroll
            for (int bj = 0; bj < 2; ++bj) {
                const int c0 = u.pn * BM + bj * HALF + wc * 32 + 8 * fq, h = c0 / 192, d0 = c0 - h * 192;
                const int cg = u.pn * BM + bj * HALF + wc * 32, dg = cg - (cg / 192) * 192;
                if (lat && dg >= 128) {
                    const int r0 = d0 - 128;
                    f32x4 c01s[4], c23s[4];
#pragma unroll
                    for (int m = 0; m < 4; ++m) { const int prow = (pmb - 1) * 4 + 2 * ai + wr, pcol = 16 * m + fr;
                        const float2* tp = T64 + ((r0 >> 5) ? pcol : prow) * 16 + ((r0 >> 1) & 15); c01s[m] = *(const f32x4*)tp; c23s[m] = *(const f32x4*)(tp + 2); }
                    __builtin_amdgcn_sched_barrier(0);
#pragma unroll
                    for (int m = 0; m < 4; ++m) { const f32x4 c01 = c01s[m], c23 = c23s[m];
                        const float cs[4] = {c01[0], c01[2], c23[0], c23[2]}, sn[4] = {c01[1], c01[3], c23[1], c23[3]}; float v[8];
#pragma unroll
                        for (int p = 0; p < 4; ++p) { const float x1 = acc[ai][bj][m][p >> 1][(2 * p) & 3] * rstd[m], x2 = acc[ai][bj][m][p >> 1][(2 * p + 1) & 3] * rstd[m]; v[2 * p] = x1 * cs[p] - x2 * sn[p]; v[2 * p + 1] = x2 * cs[p] + x1 * sn[p]; }
                        u32x4 w; w.x = cvt_pk_bf16(v[0], v[1]); w.y = cvt_pk_bf16(v[2], v[3]); w.z = cvt_pk_bf16(v[4], v[5]); w.w = cvt_pk_bf16(v[6], v[7]);
                        *(u32x4*)(QM + (size_t)(row0 + ai * HALF + m * 16) * 1536 + c0) = w; }
                } else {
#pragma unroll
                    for (int m = 0; m < 4; ++m) { const f32x4 v0 = acc[ai][bj][m][0] * rstd[m], v1 = acc[ai][bj][m][1] * rstd[m];
                        u32x4 w; w.x = cvt_pk_bf16(v0[0], v0[1]); w.y = cvt_pk_bf16(v0[2], v0[3]); w.z = cvt_pk_bf16(v1[0], v1[1]); w.w = cvt_pk_bf16(v1[2], v1[3]);
                        *(u32x4*)(QM + (size_t)(row0 + ai * HALF + m * 16) * 1536 + c0) = w; }
                }
            }
        }
    }
};
struct EpiUKV {
    __device__ __forceinline__ void prefetch(const Unit&, LAS unsigned char*, int) const {}
    static constexpr int ID = 4; static constexpr bool IDEMP = true; static constexpr bool PERM = true;
    bf16_t* KM; bf16_t* VM; const float* SSQ;
    __device__ __forceinline__ bool keep(const Unit&) const { return false; }
    __device__ __forceinline__ void operator()(f32x4 (&acc)[2][2][4][2], const Unit& u, int wr, int wc, int fr, int fq) const {
        const int row0 = u.pm * BM + wr * 64 + fr;
#pragma unroll
        for (int ai = 0; ai < 2; ++ai) {
            f32x4 s0[4], s1[4]; float rstd[4];
#pragma unroll
            for (int m = 0; m < 4; ++m) { const float* sp = SSQ + (size_t)(row0 + ai * HALF + m * 16) * 16 + 8; s0[m] = *(const f32x4*)sp; s1[m] = *(const f32x4*)(sp + 4); }
#pragma unroll
            for (int m = 0; m < 4; ++m) rstd[m] = rsqrtf(((s0[m][0] + s0[m][1]) + (s0[m][2] + s0[m][3]) + (s1[m][0] + s1[m][1]) + (s1[m][2] + s1[m][3])) * (1.0f / 512.0f) + EPS);
            if (u.pn < 4) {
#pragma unroll
                for (int m = 0; m < 4; ++m)
#pragma unroll
                    for (int bj = 0; bj < 2; ++bj) { const int c0 = u.pn * BM + bj * HALF + wc * 32 + 8 * fq; const f32x4 v0 = acc[ai][bj][m][0] * rstd[m], v1 = acc[ai][bj][m][1] * rstd[m];
                        u32x4 w; w.x = cvt_pk_bf16(v0[0], v0[1]); w.y = cvt_pk_bf16(v0[2], v0[3]); w.z = cvt_pk_bf16(v1[0], v1[1]); w.w = cvt_pk_bf16(v1[2], v1[3]);
                        *(u32x4*)(KM + (size_t)(row0 + ai * HALF + m * 16) * 1536 + (c0 >> 7) * 192 + (c0 & 127)) = w; }
            } else {
#pragma unroll
                for (int m = 0; m < 4; ++m)
#pragma unroll
                    for (int bj = 0; bj < 2; ++bj) { const int c0 = u.pn * BM + bj * HALF + wc * 32 + 8 * fq; const f32x4 v0 = acc[ai][bj][m][0] * rstd[m], v1 = acc[ai][bj][m][1] * rstd[m];
                        u32x4 w; w.x = cvt_pk_bf16(v0[0], v0[1]); w.y = cvt_pk_bf16(v0[2], v0[3]); w.z = cvt_pk_bf16(v1[0], v1[1]); w.w = cvt_pk_bf16(v1[2], v1[3]);
                        *(u32x4*)(VM + (size_t)(row0 + ai * HALF + m * 16) * 1024 + (c0 - 1024)) = w; }
            }
        }
    }
};
struct EpiUQKV {
    __device__ __forceinline__ void prefetch(const Unit&, LAS unsigned char*, int) const {}
    static constexpr int ID = 7; static constexpr bool IDEMP = true; static constexpr bool PERM = true;
    EpiUQ q; EpiUKV kv;
    __device__ __forceinline__ bool keep(const Unit&) const { return false; }
    __device__ __forceinline__ void operator()(f32x4 (&acc)[2][2][4][2], const Unit& u, int wr, int wc, int fr, int fq) const {
        if (u.pn < 6) q(acc, u, wr, wc, fr, fq);
        else { Unit v = u; v.pn = u.pn - 6; kv(acc, v, wr, wc, fr, fq); }
    }
};
struct EpiSwiGlu {
    __device__ __forceinline__ void prefetch(const Unit&, LAS unsigned char*, int) const {}
    static constexpr int ID = 5; static constexpr bool IDEMP = true; static constexpr bool PERM = true;
    bf16_t* O;
    __device__ __forceinline__ bool keep(const Unit&) const { return false; }
    __device__ __forceinline__ void operator()(f32x4 (&acc)[2][2][4][2], const Unit& u, int wr, int wc, int fr, int fq) const {
        const int row0 = u.pm * BM + wr * 64 + fr, col0 = u.pn * HALF + wc * 32 + 8 * fq;
#pragma unroll
        for (int ai = 0; ai < 2; ++ai)
#pragma unroll
            for (int m = 0; m < 4; ++m) { bf16_t* rowp = O + (size_t)(row0 + ai * HALF + m * 16) * FF + col0;
                float h[8];
#pragma unroll
                for (int n = 0; n < 2; ++n)
#pragma unroll
                    for (int e = 0; e < 4; ++e) { const float g = acc[ai][0][m][n][e], up = acc[ai][1][m][n][e]; h[n * 4 + e] = g * __builtin_amdgcn_rcpf(1.0f + __builtin_amdgcn_exp2f(-1.4426950408889634f * g)) * up; }
                u32x4 w; w.x = cvt_pk_bf16(h[0], h[1]); w.y = cvt_pk_bf16(h[2], h[3]); w.z = cvt_pk_bf16(h[4], h[5]); w.w = cvt_pk_bf16(h[6], h[7]);
                *(u32x4*)rowp = w; }
    }
};
struct EpiMerge {
    __device__ __forceinline__ void prefetch(const Unit& u, LAS unsigned char* lds, int tid) const {
        const int wid = __builtin_amdgcn_readfirstlane(tid >> 6);
        const bf16_t* gp = G + ((size_t)u.pm * 24 + (u.seg < 2 ? u.seg : 2) * 8 + u.pn) * 65536 + (size_t)tid * 128;
        LAS unsigned* dst = (LAS unsigned*)(lds + STAGE_BYTES + 1024 + wid * 256);
        __builtin_amdgcn_global_load_lds((const unsigned*)gp, dst, 4, 0, 0);
        __builtin_amdgcn_global_load_lds((const unsigned*)(gp + 64), dst, 4, 0, 0);
        if (u.seg < 2) { __builtin_amdgcn_global_load_lds((const unsigned*)(gp + 8 * 65536), dst, 4, 0, 0); __builtin_amdgcn_global_load_lds((const unsigned*)(gp + 8 * 65536 + 64), dst, 4, 0, 0); }
    }
    static constexpr int ID = 6; static constexpr bool IDEMP = false; static constexpr bool PERM = true;
    const bf16_t* G;
    bf16_t* O;
    bf16_t* PM = nullptr; unsigned* cnt = nullptr;
    __device__ __forceinline__ bool keep(const Unit& u) const { return u.seg < 2 && u.nt == 0; }
    __device__ __forceinline__ void operator()(f32x4 (&acc)[2][2][4][2], const Unit& u, int wr, int wc, int fr, int fq) const {
        const int row0 = u.pm * BM + wr * 64 + fr, col0 = u.pn * BM + wc * 32 + 8 * fq;
        const bf16_t* gl = G + ((size_t)u.pm * 24 + u.pn) * 65536 + ((size_t)(wr * 4 + wc) * 16 * 64 + fq * 16 + fr) * 8;
        if (u.nt) {
            const int tile = (u.pm - 64) * 8 + u.pn, w = wr * 4 + wc;
            const auto rsrc = __builtin_amdgcn_make_buffer_rsrc((void*)PM, 0, 96 * 131072, 0x00020000);
            const unsigned pbase = (unsigned)(tile * 3) * 131072u + (unsigned)((w * 16 * 64 + fq * 16 + fr) * 16);
#pragma unroll
            for (int ai = 0; ai < 2; ++ai) {
                u32x4 ra[4][2];
#pragma unroll
                for (int m = 0; m < 4; ++m)
#pragma unroll
                    for (int bj = 0; bj < 2; ++bj) ra[m][bj] = *(const u32x4*)(gl + (size_t)u.seg * 8 * 65536 + ((ai * 4 + m) * 2 + bj) * 512);
#pragma unroll
                for (int m = 0; m < 4; ++m)
#pragma unroll
                    for (int bj = 0; bj < 2; ++bj) { float f[8]; unpack8(ra[m][bj], f);
                        const f32x4 v0 = acc[ai][bj][m][0], v1 = acc[ai][bj][m][1];
                        u32x4 wv; wv.x = cvt_pk_bf16(v0[0] * f[0], v0[1] * f[1]); wv.y = cvt_pk_bf16(v0[2] * f[2], v0[3] * f[3]); wv.z = cvt_pk_bf16(v1[0] * f[4], v1[1] * f[5]); wv.w = cvt_pk_bf16(v1[2] * f[6], v1[3] * f[7]);
                        __builtin_amdgcn_raw_buffer_store_b128(wv, rsrc, pbase + (unsigned)u.seg * 131072u + (unsigned)(((ai * 4 + m) * 2 + bj) * 1024), 0,   16); }
            }
            asm volatile("s_waitcnt vmcnt(0)" ::: "memory");
            unsigned old = 0; if ((fq | fr) == 0) old = __hip_atomic_fetch_add(cnt + tile * 8 + w, 1u, __ATOMIC_RELAXED, __HIP_MEMORY_SCOPE_AGENT);
            old = (unsigned)__builtin_amdgcn_readfirstlane((int)old);
            if (old == 2) {
                __builtin_amdgcn_fence(__ATOMIC_ACQUIRE, "agent"); asm volatile("s_waitcnt vmcnt(0)" ::: "memory");
                const bf16_t* pp = PM + (size_t)tile * 3 * 65536 + ((size_t)w * 16 * 64 + fq * 16 + fr) * 8;
#pragma unroll
                for (int am = 0; am < 4; ++am) { const int ai = am >> 1, mb = (am & 1) * 2;
                    u32x4 rp[2][2][3];
#pragma unroll
                    for (int mm = 0; mm < 2; ++mm)
#pragma unroll
                        for (int bj = 0; bj < 2; ++bj)
#pragma unroll
                            for (int s = 0; s < 3; ++s) rp[mm][bj][s] = *(const u32x4*)(pp + (size_t)s * 65536 + ((ai * 4 + mb + mm) * 2 + bj) * 512);
#pragma unroll
                    for (int mm = 0; mm < 2; ++mm)
#pragma unroll
                        for (int bj = 0; bj < 2; ++bj) { float a[8], b[8], c3[8]; unpack8(rp[mm][bj][0], a); unpack8(rp[mm][bj][1], b); unpack8(rp[mm][bj][2], c3);
#pragma unroll
                            for (int e = 0; e < 8; ++e) a[e] = (a[e] + b[e]) + c3[e];
                            *(u32x4*)(O + (size_t)(row0 + ai * HALF + (mb + mm) * 16) * LDM + col0 + bj * HALF) = pack8(a); }
                }
            }
        } else if (u.seg < 2) {
            const bf16_t* gbase = gl + (size_t)u.seg * 8 * 65536;
#pragma unroll
            for (int am = 0; am < 4; ++am) { const int ai = am >> 1, mb = (am & 1) * 2;
                u32x4 ra[2][2], rb[2][2];
#pragma unroll
                for (int mm = 0; mm < 2; ++mm)
#pragma unroll
                    for (int bj = 0; bj < 2; ++bj) { const bf16_t* gp = gbase + ((ai * 4 + mb + mm) * 2 + bj) * 512; ra[mm][bj] = *(const u32x4*)gp; rb[mm][bj] = *(const u32x4*)(gp + 8 * 65536); }
#pragma unroll
                for (int mm = 0; mm < 2; ++mm)
#pragma unroll
                    for (int bj = 0; bj < 2; ++bj) { const int m = mb + mm; float ga[8], gb[8]; unpack8(ra[mm][bj], ga); unpack8(rb[mm][bj], gb);
                        f32x4 v0 = acc[ai][bj][m][0], v1 = acc[ai][bj][m][1];
                        v0[0] *= ga[0] * __builtin_amdgcn_rcpf(gb[0]); v0[1] *= ga[1] * __builtin_amdgcn_rcpf(gb[1]); v0[2] *= ga[2] * __builtin_amdgcn_rcpf(gb[2]); v0[3] *= ga[3] * __builtin_amdgcn_rcpf(gb[3]);
                        v1[0] *= ga[4] * __builtin_amdgcn_rcpf(gb[4]); v1[1] *= ga[5] * __builtin_amdgcn_rcpf(gb[5]); v1[2] *= ga[6] * __builtin_amdgcn_rcpf(gb[6]); v1[3] *= ga[7] * __builtin_amdgcn_rcpf(gb[7]);
                        acc[ai][bj][m][0] = v0; acc[ai][bj][m][1] = v1; }
            }
        } else {
#pragma unroll
            for (int ai = 0; ai < 2; ++ai) {
                u32x4 ra[4][2];
#pragma unroll
                for (int m = 0; m < 4; ++m)
#pragma unroll
                    for (int bj = 0; bj < 2; ++bj) ra[m][bj] = *(const u32x4*)(gl + (size_t)2 * 8 * 65536 + ((ai * 4 + m) * 2 + bj) * 512);
#pragma unroll
                for (int m = 0; m < 4; ++m)
#pragma unroll
                    for (int bj = 0; bj < 2; ++bj) { float f[8]; unpack8(ra[m][bj], f);
                        const f32x4 v0 = acc[ai][bj][m][0], v1 = acc[ai][bj][m][1];
                        u32x4 w; w.x = cvt_pk_bf16(v0[0] * f[0], v0[1] * f[1]); w.y = cvt_pk_bf16(v0[2] * f[2], v0[3] * f[3]); w.z = cvt_pk_bf16(v1[0] * f[4], v1[1] * f[5]); w.w = cvt_pk_bf16(v1[2] * f[6], v1[3] * f[7]);
                        *(u32x4*)(O + (size_t)(row0 + ai * HALF + m * 16) * LDM + col0 + bj * HALF) = w; }
            }
        }
    }
};

template <class Epi, class Sched>
__device__ __forceinline__ void gemm_phase(LAS unsigned char* lds, const Gemm g, const Sched& S, const Epi& E) {
    const int tid = fresh_tid(), wid = __builtin_amdgcn_readfirstlane(tid >> 6), lane = tid & 63, wr = wid >> 2, wc = wid & 3, fr = lane & 15, fq = lane >> 4;
    const int K = g.K, nt = K / BK;
    unsigned voffA[2], voffB[2];
#pragma unroll
    for (int i = 0; i < 2; ++i) { int R, C; stage_rc(tid * 16 + i * 8192, R, C); const int Rb = Epi::PERM ? ((R & ~31) + perm32(R & 31)) : R;
        voffA[i] = (unsigned)(R * g.lda + C) * 2u; voffB[i] = (unsigned)(Rb * g.ldb + C) * 2u; }
    const size_t kstep = (size_t)(BK * 2);
    const size_t hstepA = (size_t)HALF * g.lda * 2, hstepB = (size_t)HALF * g.ldb * 2;
    const size_t tstepA = 2 * hstepA, tstepB = 2 * hstepB;
    const unsigned ldsw = (unsigned)wid * 1024u;
    const int aoff = lds_byte(wr * 64 + fr, fq * 8), boff = lds_byte(wc * 32 + fr, fq * 8);
#define PG8_SA(b, h) (((b) * 2 + (h)) * HTB)
#define PG8_SB(b, h) ((4 + (b) * 2 + (h)) * HTB)
#define PG8_STAGE(bufoff, gbase, voff) do { _Pragma("unroll") for (int _i = 0; _i < 2; ++_i) \
        __builtin_amdgcn_global_load_lds((const unsigned*)((const char*)(gbase) + (voff)[_i]), (LAS unsigned*)(lds + (bufoff) + ldsw + _i * 8192), 16, 0, 0); } while (0)
#define PG8_LDA(dst, b, h) do { _Pragma("unroll") for (int m = 0; m < 4; ++m) _Pragma("unroll") for (int k = 0; k < 2; ++k) dst[m][k] = *(const LAS bf16x8*)(lds + PG8_SA(b, h) + aoff + m * 2048 + k * 1024); } while (0)
#define PG8_LDB(dst, b, h) do { _Pragma("unroll") for (int n = 0; n < 2; ++n) _Pragma("unroll") for (int k = 0; k < 2; ++k) dst[n][k] = *(const LAS bf16x8*)(lds + PG8_SB(b, h) + boff + n * 2048 + k * 1024); } while (0)
#define PG8_MMA(ai, bj, At, Bt) do { __builtin_amdgcn_s_setprio(1); _Pragma("unroll") for (int m = 0; m < 4; ++m) _Pragma("unroll") for (int n = 0; n < 2; ++n) _Pragma("unroll") for (int k = 0; k < 2; ++k) \
        acc[ai][bj][m][n] = __builtin_amdgcn_mfma_f32_16x16x32_bf16(Bt[n][k], At[m][k], acc[ai][bj][m][n], 0, 0, 0); __builtin_amdgcn_s_setprio(0); } while (0)
#define PG8_WAIT_V(n) asm volatile("s_waitcnt vmcnt(" #n ")" ::: "memory")
#define PG8_WAIT_L(n) asm volatile("s_waitcnt lgkmcnt(" #n ")" ::: "memory")
#define PG8_BAR __builtin_amdgcn_s_barrier()
#define PG8_SCHED __builtin_amdgcn_sched_barrier(0)
    Unit cur, nxt; int ui = 0;
    if (!S.next(0, cur)) return;
    f32x4 acc[2][2][4][2];
#pragma unroll
    for (int a = 0; a < 2; ++a)
#pragma unroll
        for (int b = 0; b < 2; ++b)
#pragma unroll
            for (int m = 0; m < 4; ++m)
#pragma unroll
                for (int n = 0; n < 2; ++n) acc[a][b][m][n] = (f32x4){0.f, 0.f, 0.f, 0.f};
    bf16x8 At[4][2], B0[2][2], B1[2][2];
    const char* cA = (const char*)g.A + (size_t)cur.seg * g.segA + (size_t)cur.pm * tstepA; const char* cB = (const char*)g.Bt + (size_t)cur.seg * g.segB + (size_t)cur.pn * tstepB;
    S.a_ready(cur);
    PG8_STAGE(PG8_SB(0, 0), cB, voffB); PG8_STAGE(PG8_SA(0, 0), cA, voffA); PG8_STAGE(PG8_SB(0, 1), cB + hstepB, voffB); PG8_STAGE(PG8_SA(0, 1), cA + hstepA, voffA);
    if (wr == 1) PG8_BAR;
    PG8_WAIT_V(4); PG8_BAR;
    PG8_STAGE(PG8_SB(1, 0), cB + kstep, voffB); PG8_STAGE(PG8_SA(1, 0), cA + kstep, voffA); PG8_STAGE(PG8_SB(1, 1), cB + hstepB + kstep, voffB);
    PG8_WAIT_V(6); PG8_BAR;
    for (;;) {
        E.prefetch(cur, lds, tid);
        const bool has_next = S.next(ui + 1, nxt);
        const char* nA = has_next ? (const char*)g.A + (size_t)nxt.seg * g.segA + (size_t)nxt.pm * tstepA : cA;
        const char* nB = has_next ? (const char*)g.Bt + (size_t)nxt.seg * g.segB + (size_t)nxt.pn * tstepB : cB;
        const int ntu = cur.nt ? cur.nt : nt;
        for (int t = 0; t < ntu; t += 2) {
            const bool last = (t == ntu - 2);
            const char* a1 = cA + (size_t)(t + 1) * kstep;
            const char* a2 = last ? nA : cA + (size_t)(t + 2) * kstep; const char* b2 = last ? nB : cB + (size_t)(t + 2) * kstep;
            const char* a3 = a2 + kstep; const char* b3 = b2 + kstep;
            if (last && has_next) S.a_ready(nxt);
            PG8_LDB(B0, 0, 0); PG8_SCHED; PG8_LDA(At, 0, 0); PG8_STAGE(PG8_SA(1, 1), a1 + hstepA, voffA);
            PG8_WAIT_L(8); PG8_BAR; PG8_WAIT_L(0); PG8_MMA(0, 0, At, B0); PG8_BAR; PG8_SCHED;
            PG8_LDB(B1, 0, 1); PG8_STAGE(PG8_SB(0, 0), b2, voffB);
            PG8_BAR; PG8_WAIT_L(0); PG8_MMA(0, 1, At, B1); PG8_BAR;
            PG8_LDA(At, 0, 1); PG8_STAGE(PG8_SA(0, 0), a2, voffA);
            PG8_BAR; PG8_WAIT_L(0); PG8_MMA(1, 0, At, B0); PG8_BAR; PG8_SCHED;
            PG8_STAGE(PG8_SB(0, 1), b2 + hstepB, voffB);
            PG8_WAIT_V(6); PG8_BAR; PG8_MMA(1, 1, At, B1); PG8_BAR;
            PG8_LDB(B0, 1, 0); PG8_SCHED; PG8_LDA(At, 1, 0); PG8_STAGE(PG8_SA(0, 1), a2 + hstepA, voffA);
            PG8_WAIT_L(8); PG8_BAR; PG8_WAIT_L(0); PG8_MMA(0, 0, At, B0); PG8_BAR; PG8_SCHED;
            PG8_LDB(B1, 1, 1); PG8_STAGE(PG8_SB(1, 0), b3, voffB);
            PG8_BAR; PG8_WAIT_L(0); PG8_MMA(0, 1, At, B1); PG8_BAR;
            PG8_LDA(At, 1, 1); PG8_STAGE(PG8_SA(1, 0), a3, voffA);
            PG8_BAR; PG8_WAIT_L(0); PG8_MMA(1, 0, At, B0); PG8_BAR; PG8_SCHED;
            PG8_STAGE(PG8_SB(1, 1), b3 + hstepB, voffB);
            PG8_WAIT_V(6); PG8_BAR; PG8_MMA(1, 1, At, B1); PG8_BAR;
        }
        E(acc, cur, wr, wc, fr, fq); S.done(cur);
#if defined(PROBE_EPI2)
        if constexpr (Epi::IDEMP && ((PROBE_EPI2 >> Epi::ID) & 1)) { asm volatile("" ::: "memory"); E(acc, cur, wr, wc, fr, fq); }
#endif
        if (!has_next) break;
        if (!E.keep(cur)) {
#pragma unroll
            for (int a = 0; a < 2; ++a)
#pragma unroll
                for (int b = 0; b < 2; ++b)
#pragma unroll
                    for (int m = 0; m < 4; ++m)
#pragma unroll
                        for (int n = 0; n < 2; ++n) acc[a][b][m][n] = (f32x4){0.f, 0.f, 0.f, 0.f};
        }
        cur = nxt; cA = nA; cB = nB; ++ui;
    }
    PG8_WAIT_V(0);
    if (wr == 0) PG8_BAR;
    PG8_BAR;
#undef PG8_SA
#undef PG8_SB
#undef PG8_STAGE
#undef PG8_LDA
#undef PG8_LDB
#undef PG8_MMA
#undef PG8_WAIT_V
#undef PG8_WAIT_L
#undef PG8_BAR
#undef PG8_SCHED
}
}

namespace att {
constexpr int NW = 8, QBLK = 32, KVBLK = 64, DV = 128;
constexpr float THR = 8.f;
#define SBAR() __builtin_amdgcn_sched_barrier(0)
__device__ __forceinline__ int crow(int r, int hi) { return (r & 3) + 8 * (r >> 2) + 4 * hi; }
__device__ __forceinline__ unsigned cvtpk(float lo, float hi) { return pg8::cvt_pk_bf16(lo, hi); }

__device__ __forceinline__ void partialSM(f32x16& p0, f32x16& p1, float& m_reg, float& mn, float& alpha, const float C, const float thr_s) {
  float pmax = p0[0];
#pragma unroll
  for (int r = 1; r < 16; ++r) pmax = fmaxf(pmax, p0[r]);
#pragma unroll
  for (int r = 0; r < 16; ++r) pmax = fmaxf(pmax, p1[r]);
  { auto rr = __builtin_amdgcn_permlane32_swap(__float_as_uint(pmax), __float_as_uint(pmax), false, false);
    pmax = fmaxf(__uint_as_float(rr[0]), __uint_as_float(rr[1])); }
  if (__builtin_expect(__all(pmax - m_reg <= thr_s), 1)) { mn = m_reg; alpha = 1.f; }
  else { mn = fmaxf(m_reg, pmax); alpha = __builtin_amdgcn_exp2f((m_reg - mn) * C); m_reg = mn; }
  float mnC = -mn * C;
#pragma unroll
  for (int r = 0; r < 16; ++r) p0[r] = fmaf(p0[r], C, mnC);
#pragma unroll
  for (int r = 0; r < 16; ++r) p1[r] = fmaf(p1[r], C, mnC);
#pragma unroll
  for (int r = 0; r < 16; ++r) p0[r] = __builtin_amdgcn_exp2f(p0[r]);
}
__device__ __forceinline__ void finishSM(f32x16& p0, f32x16& p1, float alpha, float& l_reg, bf16x8& pa0, bf16x8& pa1, bf16x8& pa2, bf16x8& pa3) {
#pragma unroll
  for (int r = 0; r < 16; ++r) p1[r] = __builtin_amdgcn_exp2f(p1[r]);
  float ps = 0;
#pragma unroll
  for (int r = 0; r < 16; ++r) ps += p0[r];
#pragma unroll
  for (int r = 0; r < 16; ++r) ps += p1[r];
  { auto rr = __builtin_amdgcn_permlane32_swap(__float_as_uint(ps), __float_as_uint(ps), false, false);
    ps = __uint_as_float(rr[0]) + __uint_as_float(rr[1]); }
  l_reg = l_reg * alpha + ps;
#define PK4(P, BASE, OUT) do { unsigned a0 = cvtpk(P[BASE + 0], P[BASE + 1]), a1 = cvtpk(P[BASE + 2], P[BASE + 3]);   \
    unsigned b0 = cvtpk(P[BASE + 4], P[BASE + 5]), b1 = cvtpk(P[BASE + 6], P[BASE + 7]);                              \
    auto r0 = __builtin_amdgcn_permlane32_swap(a0, b0, false, false); auto r1 = __builtin_amdgcn_permlane32_swap(a1, b1, false, false); \
    u32x4 w = {r0[0], r1[0], r0[1], r1[1]}; OUT = *reinterpret_cast<bf16x8*>(&w); } while (0)
  PK4(p0, 0, pa0); PK4(p0, 8, pa1); PK4(p1, 0, pa2); PK4(p1, 8, pa3);
#undef PK4
}
template <int DK>
__device__ __forceinline__ void qkt(f32x16& p0, f32x16& p1, const char* Ks, const bf16x8* qr, int r32, int hi) {
  p0 = f32x16{}; p1 = f32x16{};
#pragma unroll
  for (int d0 = 0; d0 < DK / 16; ++d0) { const int cb = (d0 * 16 + hi * 8) * 2;
    bf16x8 b0 = *reinterpret_cast<const bf16x8*>(Ks + r32 * (DK * 2) + (cb ^ ((r32 & 7) << 4)));
    bf16x8 b1 = *reinterpret_cast<const bf16x8*>(Ks + (32 + r32) * (DK * 2) + (cb ^ ((r32 & 7) << 4)));
    p0 = __builtin_amdgcn_mfma_f32_32x32x16_bf16(b0, qr[d0], p0, 0, 0, 0);
    p1 = __builtin_amdgcn_mfma_f32_32x32x16_bf16(b1, qr[d0], p1, 0, 0, 0); }
}
__device__ __forceinline__ int v_st(int k, int c) { const int kk = (k & ~0xC) | ((k & 4) << 1) | ((k & 8) >> 1); return ((kk >> 3) * 4 + (c >> 5)) * 512 + ((kk & 7) * 32 + (c & 31)) * 2; }
__device__ __forceinline__ int v_rd_base(int lane) { return ((lane & 3) << 3) | (((lane >> 2) & 3) << 6) | (((lane >> 4) & 1) << 5) | (((lane >> 5) & 1) << 8); }
constexpr int v_rd_off(int d0, int ks, int half) { return d0 * 512 + ks * 4096 + half * 2048; }
template <int OFF> __device__ __forceinline__ s16x4 tr_read(int vb) {
  s16x4 r; asm volatile("ds_read_b64_tr_b16 %0, %1 offset:%2" : "=&v"(r) : "v"(vb), "i"(OFF) : "memory"); return r;
}
template <int D0> __device__ __forceinline__ void pv_one(f32x16& od, int vb, bf16x8 pa0, bf16x8 pa1, bf16x8 pa2, bf16x8 pa3) {
  const s16x4 l0 = tr_read<v_rd_off(D0, 0, 0)>(vb), h0 = tr_read<v_rd_off(D0, 0, 1)>(vb), l1 = tr_read<v_rd_off(D0, 1, 0)>(vb), h1 = tr_read<v_rd_off(D0, 1, 1)>(vb);
  const s16x4 l2 = tr_read<v_rd_off(D0, 2, 0)>(vb), h2 = tr_read<v_rd_off(D0, 2, 1)>(vb), l3 = tr_read<v_rd_off(D0, 3, 0)>(vb), h3 = tr_read<v_rd_off(D0, 3, 1)>(vb);
  asm volatile("s_waitcnt lgkmcnt(0)" ::: "memory"); SBAR();
#define PK(L, H) (bf16x8){L[0], L[1], L[2], L[3], H[0], H[1], H[2], H[3]}
  od = __builtin_amdgcn_mfma_f32_32x32x16_bf16(pa0, PK(l0, h0), od, 0, 0, 0);
  od = __builtin_amdgcn_mfma_f32_32x32x16_bf16(pa1, PK(l1, h1), od, 0, 0, 0);
  od = __builtin_amdgcn_mfma_f32_32x32x16_bf16(pa2, PK(l2, h2), od, 0, 0, 0);
  od = __builtin_amdgcn_mfma_f32_32x32x16_bf16(pa3, PK(l3, h3), od, 0, 0, 0);
#undef PK
}
__device__ __forceinline__ void pv_d0(f32x16* o, int vb, bf16x8 pa0, bf16x8 pa1, bf16x8 pa2, bf16x8 pa3) {
  pv_one<0>(o[0], vb, pa0, pa1, pa2, pa3); pv_one<1>(o[1], vb, pa0, pa1, pa2, pa3); pv_one<2>(o[2], vb, pa0, pa1, pa2, pa3); pv_one<3>(o[3], vb, pa0, pa1, pa2, pa3);
}
__device__ __forceinline__ void ostore(float* p, float v) { *p = v; }
__device__ __forceinline__ void ostore(bf16_t* p, float v) { *p = (bf16_t)f2bf(v); }

template <int DK, int LDQ, int LDK, int LDV, int LDO, typename TOut, bool PIPE>
__device__ __forceinline__ void attn_body(const bf16_t* Qb, const bf16_t* Kh, const bf16_t* Vh, TOut* Ob, int seq, char* lds) {
  constexpr int SDEPTH = 1;
  constexpr int KPR = DK / 8;
  constexpr int KP = 64 * KPR / 512;
  constexpr size_t SHM_V = KVBLK * DV * 2, SHM_K = KVBLK * DK * 2;
  constexpr float SCALE = (DK == 128) ? 0.08838834764831845f : 0.07216878364870323f;
  constexpr float C = SCALE * 1.4426950408889634f, THR_S = THR / SCALE;
  const int tid = fresh_tid(), wid = tid >> 6, lane = tid & 63, r32 = lane & 31, hi = lane >> 5;
  char* V_lds = lds; char* K_lds = lds + 2 * SHM_V;
  float* ws = (float*)(lds + 2 * SHM_V + 2 * SHM_K) + wid * 64; float* li_l = ws; float* al_l = ws + 32;
  float m_reg = -1e30f, l_reg = 0; f32x16 o[4] = {}; bf16x8 qr[DK / 16];
  const bf16_t* Qw = Qb + (long)(wid * QBLK + r32) * LDQ + hi * 8;
#pragma unroll
  for (int d0 = 0; d0 < DK / 16; ++d0) qr[d0] = *reinterpret_cast<const bf16x8*>(Qw + d0 * 16);
  const int sr = tid >> 4, sc = (tid & 15) * 8, vst0 = v_st(sr, sc), vst1 = v_st(32 + sr, sc);
#define KROW(q) ((tid + 512 * (q)) / KPR)
#define KC8(q) ((tid + 512 * (q)) % KPR)
  const int vb0 = (int)(uintptr_t)V_lds + v_rd_base(lane);
  struct { bf16x8 vs0, vs1, ks[KP]; } sr_[SDEPTH];
  const unsigned voffV = (unsigned)(sr * LDV + sc) * 2u;
#define SLOAD(i, k0) do { const char* _vb = (const char*)Vh + (size_t)(k0) * (LDV * 2); const char* _kb = (const char*)Kh + (size_t)(k0) * (LDK * 2); \
    sr_[i].vs0 = *reinterpret_cast<const bf16x8*>(_vb + voffV); sr_[i].vs1 = *reinterpret_cast<const bf16x8*>(_vb + (size_t)32 * LDV * 2 + voffV); \
    _Pragma("unroll") for (int _q = 0; _q < KP; ++_q) sr_[i].ks[_q] = *reinterpret_cast<const bf16x8*>(_kb + (unsigned)(KROW(_q) * LDK + KC8(_q) * 8) * 2u); } while (0)
#define SWRITE(b, i) do { *(bf16x8*)(V_lds + (b) * SHM_V + vst0) = sr_[i].vs0; *(bf16x8*)(V_lds + (b) * SHM_V + vst1) = sr_[i].vs1; \
    _Pragma("unroll") for (int _q = 0; _q < KP; ++_q) *(bf16x8*)(K_lds + (b) * SHM_K + KROW(_q) * (DK * 2) + ((KC8(_q) * 16) ^ ((KROW(_q) & 7) << 4))) = sr_[i].ks[_q]; } while (0)
#define SWAIT() do { if constexpr (SDEPTH == 2) asm volatile("s_waitcnt vmcnt(4)" ::: "memory"); else asm volatile("s_waitcnt vmcnt(0)" ::: "memory"); } while (0)
#define RESC(a) do { if (__any((a) < 1.f)) { if (hi == 0) al_l[r32] = (a); asm volatile("s_waitcnt lgkmcnt(0)" ::: "memory"); \
    _Pragma("unroll") for (int d = 0; d < 4; ++d) _Pragma("unroll") for (int r = 0; r < 16; ++r) o[d][r] *= al_l[crow(r, hi)]; } } while (0)
  bf16x8 pa0, pa1, pa2, pa3; const int NT = seq / KVBLK;
  if constexpr (PIPE) {
  f32x16 pA0, pA1, pB0, pB1; float mnA, mnB, alA, alB;
  constexpr int SE = 0, SO = SDEPTH - 1;
  SLOAD(SE, 0); asm volatile("s_waitcnt vmcnt(0)" ::: "memory"); SWRITE(0, SE); __syncthreads();
  qkt<DK>(pA0, pA1, K_lds, qr, r32, hi); partialSM(pA0, pA1, m_reg, mnA, alA, C, THR_S);
  SLOAD(SO, KVBLK); if constexpr (SDEPTH == 2) { if (2 < NT) SLOAD(SE, 2 * KVBLK); }
  SWAIT(); SWRITE(1, SO); __syncthreads();
  for (int j = 1; j + 1 < NT; j += 2) {
    SBAR(); qkt<DK>(pB0, pB1, K_lds + SHM_K, qr, r32, hi);
    finishSM(pA0, pA1, alA, l_reg, pa0, pa1, pa2, pa3); SBAR();
    SLOAD(SO, (j + SDEPTH) * KVBLK); SBAR();
    pv_d0(o, vb0, pa0, pa1, pa2, pa3); partialSM(pB0, pB1, m_reg, mnB, alB, C, THR_S);
    __syncthreads(); SWAIT(); SWRITE(0, SE);
    RESC(alB); __syncthreads();
    SBAR(); qkt<DK>(pA0, pA1, K_lds, qr, r32, hi);
    finishSM(pB0, pB1, alB, l_reg, pa0, pa1, pa2, pa3); SBAR();
    if (SDEPTH == 1 || j + 3 < NT) SLOAD(SE, (j + 1 + SDEPTH) * KVBLK); SBAR();
    pv_d0(o, vb0 + (int)SHM_V, pa0, pa1, pa2, pa3); partialSM(pA0, pA1, m_reg, mnA, alA, C, THR_S);
    __syncthreads(); SWAIT(); SWRITE(1, SO);
    RESC(alA); __syncthreads();
  }
  SBAR(); qkt<DK>(pB0, pB1, K_lds + SHM_K, qr, r32, hi);
  finishSM(pA0, pA1, alA, l_reg, pa0, pa1, pa2, pa3); SBAR();
  pv_d0(o, vb0, pa0, pa1, pa2, pa3); partialSM(pB0, pB1, m_reg, mnB, alB, C, THR_S);
  __syncthreads(); RESC(alB);
  finishSM(pB0, pB1, alB, l_reg, pa0, pa1, pa2, pa3); SBAR();
  pv_d0(o, vb0 + (int)SHM_V, pa0, pa1, pa2, pa3);
  } else {
    f32x16 p0, p1; float mn, al;
    SLOAD(0, 0); asm volatile("s_waitcnt vmcnt(0)" ::: "memory"); SWRITE(0, 0); __syncthreads();
    for (int j = 0; j < NT; ++j) {
      const int bsel = j & 1;
      if (j + 1 < NT) SLOAD(0, (j + 1) * KVBLK);
      SBAR(); qkt<DK>(p0, p1, K_lds + bsel * SHM_K, qr, r32, hi);
      partialSM(p0, p1, m_reg, mn, al, C, THR_S);
      RESC(al);
      finishSM(p0, p1, al, l_reg, pa0, pa1, pa2, pa3); SBAR();
      pv_d0(o, vb0 + bsel * (int)SHM_V, pa0, pa1, pa2, pa3);
      if (j + 1 < NT) { asm volatile("s_waitcnt vmcnt(0)" ::: "memory"); SWRITE(bsel ^ 1, 0); }
      __syncthreads();
    }
  }
  if (hi == 0) li_l[r32] = l_reg; asm volatile("s_waitcnt lgkmcnt(0)" ::: "memory");
  float rli[16];
#pragma unroll
  for (int r = 0; r < 16; ++r) rli[r] = __builtin_amdgcn_rcpf(li_l[crow(r, hi)]);
  TOut* Ow = Ob + (long)(wid * QBLK) * LDO;
#pragma unroll
  for (int r = 0; r < 16; ++r) { const int orow = crow(r, hi);
#pragma unroll
    for (int d0 = 0; d0 < 4; ++d0) ostore(&Ow[(long)orow * LDO + d0 * 32 + r32], o[d0][r] * rli[r]); }
#undef SLOAD
#undef SWRITE
#undef SWAIT
#undef RESC
#undef KROW
#undef KC8
}

constexpr int VRS = 288;
template <int OFF> __device__ __forceinline__ s16x4 tr16(int vb) { return tr_read<OFF>(vb); }
__device__ __forceinline__ float xmax4(float v) {
  auto a = __builtin_amdgcn_permlane16_swap(__float_as_uint(v), __float_as_uint(v), false, false); v = fmaxf(__uint_as_float(a[0]), __uint_as_float(a[1]));
  auto b = __builtin_amdgcn_permlane32_swap(__float_as_uint(v), __float_as_uint(v), false, false); return fmaxf(__uint_as_float(b[0]), __uint_as_float(b[1]));
}
__device__ __forceinline__ float xsum4(float v) {
  auto a = __builtin_amdgcn_permlane16_swap(__float_as_uint(v), __float_as_uint(v), false, false); v = __uint_as_float(a[0]) + __uint_as_float(a[1]);
  auto b = __builtin_amdgcn_permlane32_swap(__float_as_uint(v), __float_as_uint(v), false, false); return __uint_as_float(b[0]) + __uint_as_float(b[1]);
}
template <int OFF> __device__ __forceinline__ bf16x8 lds_rd128(int addr) { bf16x8 r; asm volatile("ds_read_b128 %0, %1 offset:%2" : "=&v"(r) : "v"(addr), "i"(OFF) : "memory"); return r; }
template <int N> __device__ __forceinline__ void lgkm_wait() { asm volatile("s_waitcnt lgkmcnt(%0)" :: "i"(N) : "memory"); }
template <int DK, int D, int I> __device__ __forceinline__ void qk_ld(bf16x8 (&fr)[D + 1], const int (&ka)[DK / 32]) {
  constexpr int KS = DK / 32; fr[I % (D + 1)] = lds_rd128<(I / KS) * 16 * DK * 2>(ka[I % KS]);
}
template <int DK, int D, int I> __device__ __forceinline__ void qk_step(f32x4 (&s)[4][2], bf16x8 (&fr)[D + 1], const int (&ka)[DK / 32], const bf16x8 (&qr)[2][DK / 32]) {
  constexpr int KS = DK / 32, N = 4 * KS;
  if constexpr (I < N) {
    if constexpr (I + D < N) qk_ld<DK, D, I + D>(fr, ka);
    lgkm_wait<((N - 1 - I) < D ? (N - 1 - I) : D)>(); SBAR();
    constexpr int kt = I / KS, ks = I % KS;
    if constexpr (ks == 0) { s[kt][0] = __builtin_amdgcn_mfma_f32_16x16x32_bf16(fr[I % (D + 1)], qr[0][ks], (f32x4){0.f, 0.f, 0.f, 0.f}, 0, 0, 0); s[kt][1] = __builtin_amdgcn_mfma_f32_16x16x32_bf16(fr[I % (D + 1)], qr[1][ks], (f32x4){0.f, 0.f, 0.f, 0.f}, 0, 0, 0); }
    else { s[kt][0] = __builtin_amdgcn_mfma_f32_16x16x32_bf16(fr[I % (D + 1)], qr[0][ks], s[kt][0], 0, 0, 0); s[kt][1] = __builtin_amdgcn_mfma_f32_16x16x32_bf16(fr[I % (D + 1)], qr[1][ks], s[kt][1], 0, 0, 0); }
    SBAR();
    qk_step<DK, D, I + 1>(s, fr, ka, qr);
  }
}
template <int DK, int D, int I> __device__ __forceinline__ void qk_pro(bf16x8 (&fr)[D + 1], const int (&ka)[DK / 32]) { if constexpr (I < D) { qk_ld<DK, D, I>(fr, ka); qk_pro<DK, D, I + 1>(fr, ka); } }
template <int DK>
__device__ __forceinline__ void qkt16(f32x4 (&s)[4][2], const char* Ks, const bf16x8 (&qr)[2][DK / 32], int c, int g) {
  constexpr int D = 4; int ka[DK / 32]; bf16x8 fr[D + 1];
  const int kb = (int)(uintptr_t)Ks + c * (DK * 2);
#pragma unroll
  for (int ks = 0; ks < DK / 32; ++ks) ka[ks] = kb + (((ks * 32 + g * 8) * 2) ^ ((c & 7) << 4));
  qk_pro<DK, D, 0>(fr, ka); qk_step<DK, D, 0>(s, fr, ka, qr);
}
template <int DK, int D, int R> __device__ __forceinline__ void ql_ld(bf16x8 (&qa)[2][2], bf16x8 (&fr)[D + 1], const int (&qad)[DK / 32], const int (&kad)[DK / 32]) {
  constexpr int ks = R / 6, w = R % 6;
  if constexpr (w < 2) qa[ks & 1][w] = lds_rd128<w * 16 * DK * 2>(qad[ks]);
  else fr[(ks * 4 + (w - 2)) % (D + 1)] = lds_rd128<(w - 2) * 16 * DK * 2>(kad[ks]);
}
template <int DK, int D, int LO, int HI> __device__ __forceinline__ void ql_issue(bf16x8 (&qa)[2][2], bf16x8 (&fr)[D + 1], const int (&qad)[DK / 32], const int (&kad)[DK / 32]) {
  if constexpr (LO <= HI) { ql_ld<DK, D, LO>(qa, fr, qad, kad); ql_issue<DK, D, LO + 1, HI>(qa, fr, qad, kad); }
}
template <int DK, int D, int J> __device__ __forceinline__ void ql_step(f32x4 (&s)[4][2], bf16x8 (&qa)[2][2], bf16x8 (&fr)[D + 1], const int (&qad)[DK / 32], const int (&kad)[DK / 32]) {
  constexpr int KS = DK / 32, NR = 6 * KS, NJ = 4 * KS;
  if constexpr (J < NJ) {
    constexpr int ks = J / 4, kt = J % 4, rJ = 6 * ks + 2 + kt;
    constexpr int prevJ = J - 1, rP = J == 0 ? 0 : 6 * (prevJ / 4) + 2 + (prevJ % 4);
    constexpr int issuedP = (rP + D) < (NR - 1) ? (rP + D) : (NR - 1), issued = (rJ + D) < (NR - 1) ? (rJ + D) : (NR - 1);
    if constexpr (J > 0) ql_issue<DK, D, issuedP + 1, issued>(qa, fr, qad, kad);
    lgkm_wait<issued - rJ>(); SBAR();
    const bf16x8 kf = fr[(ks * 4 + kt) % (D + 1)];
    if constexpr (ks == 0) { s[kt][0] = __builtin_amdgcn_mfma_f32_16x16x32_bf16(kf, qa[0][0], (f32x4){0.f, 0.f, 0.f, 0.f}, 0, 0, 0); s[kt][1] = __builtin_amdgcn_mfma_f32_16x16x32_bf16(kf, qa[0][1], (f32x4){0.f, 0.f, 0.f, 0.f}, 0, 0, 0); }
    else { s[kt][0] = __builtin_amdgcn_mfma_f32_16x16x32_bf16(kf, qa[ks & 1][0], s[kt][0], 0, 0, 0); s[kt][1] = __builtin_amdgcn_mfma_f32_16x16x32_bf16(kf, qa[ks & 1][1], s[kt][1], 0, 0, 0); }
    SBAR();
    ql_step<DK, D, J + 1>(s, qa, fr, qad, kad);
  }
}
template <int DK>
__device__ __forceinline__ void qkt16l(f32x4 (&s)[4][2], const char* Ks, const char* Qs, int c, int g) {
  constexpr int D = 3; int qad[DK / 32], kad[DK / 32]; bf16x8 qa[2][2], fr[D + 1];
  const int kb = (int)(uintptr_t)Ks + c * (DK * 2), qb = (int)(uintptr_t)Qs + c * (DK * 2);
#pragma unroll
  for (int ks = 0; ks < DK / 32; ++ks) { const int sw = ((ks * 32 + g * 8) * 2) ^ ((c & 7) << 4); kad[ks] = kb + sw; qad[ks] = qb + sw; }
  ql_issue<DK, D, 0, 2 + D>(qa, fr, qad, kad);
  ql_step<DK, D, 0>(s, qa, fr, qad, kad);
}
__device__ __forceinline__ void partialSM16(f32x4 (&s)[4][2], float (&m_reg)[2], float (&alpha)[2], const float C, const float thr_s) {
  float pmax[2];
#pragma unroll
  for (int qt = 0; qt < 2; ++qt) { float v = s[0][qt][0];
#pragma unroll
    for (int kt = 0; kt < 4; ++kt)
#pragma unroll
      for (int r = 0; r < 4; ++r) v = fmaxf(v, s[kt][qt][r]);
    pmax[qt] = xmax4(v); }
  float mn[2];
  if (__builtin_expect(__all(pmax[0] - m_reg[0] <= thr_s && pmax[1] - m_reg[1] <= thr_s), 1)) { mn[0] = m_reg[0]; mn[1] = m_reg[1]; alpha[0] = 1.f; alpha[1] = 1.f; }
  else {
#pragma unroll
    for (int qt = 0; qt < 2; ++qt) { mn[qt] = fmaxf(m_reg[qt], pmax[qt]); alpha[qt] = __builtin_amdgcn_exp2f((m_reg[qt] - mn[qt]) * C); m_reg[qt] = mn[qt]; } }
#pragma unroll
  for (int qt = 0; qt < 2; ++qt) { const float mnC = -mn[qt] * C;
#pragma unroll
    for (int kt = 0; kt < 4; ++kt)
#pragma unroll
      for (int r = 0; r < 4; ++r) s[kt][qt][r] = fmaf(s[kt][qt][r], C, mnC); }
#pragma unroll
  for (int qt = 0; qt < 2; ++qt)
#pragma unroll
    for (int kt = 0; kt < 2; ++kt)
#pragma unroll
      for (int r = 0; r < 4; ++r) s[kt][qt][r] = __builtin_amdgcn_exp2f(s[kt][qt][r]);
}
__device__ __forceinline__ void finishSM16(f32x4 (&s)[4][2], const float (&alpha)[2], float (&lp)[2], bf16x8 (&pa)[2][2]) {
#pragma unroll
  for (int qt = 0; qt < 2; ++qt)
#pragma unroll
    for (int kt = 2; kt < 4; ++kt)
#pragma unroll
      for (int r = 0; r < 4; ++r) s[kt][qt][r] = __builtin_amdgcn_exp2f(s[kt][qt][r]);
#pragma unroll
  for (int qt = 0; qt < 2; ++qt) { float ps = 0.f;
#pragma unroll
    for (int kt = 0; kt < 4; ++kt) ps += (s[kt][qt][0] + s[kt][qt][1]) + (s[kt][qt][2] + s[kt][qt][3]);
    lp[qt] = lp[qt] * alpha[qt] + ps;
#pragma unroll
    for (int kb = 0; kb < 2; ++kb) { const f32x4 a = s[2 * kb][qt], b = s[2 * kb + 1][qt];
      u32x4 w = {cvtpk(a[0], a[1]), cvtpk(a[2], a[3]), cvtpk(b[0], b[1]), cvtpk(b[2], b[3])}; pa[qt][kb] = *reinterpret_cast<bf16x8*>(&w); } }
}
template <int VT, int VRSB> __device__ __forceinline__ void pv16_ld(s16x4 (&f)[4], int vb) {
  f[0] = tr16<0 * VRSB + VT * 32>(vb); f[1] = tr16<16 * VRSB + VT * 32>(vb); f[2] = tr16<32 * VRSB + VT * 32>(vb); f[3] = tr16<48 * VRSB + VT * 32>(vb);
}
template <int NVT, int VRSB, int DP, int VT> __device__ __forceinline__ void pv16_step(f32x4 (&o)[2][NVT], int vb, const bf16x8 (&pa)[2][2], s16x4 (&f)[DP + 1][4]) {
  if constexpr (VT < NVT) {
    if constexpr (VT + DP < NVT) pv16_ld<VT + DP, VRSB>(f[(VT + DP) % (DP + 1)], vb);
    lgkm_wait<4 * ((NVT - 1 - VT) < DP ? (NVT - 1 - VT) : DP)>(); SBAR();
    s16x4 (&fa)[4] = f[VT % (DP + 1)];
#define PK(L, H) (bf16x8){L[0], L[1], L[2], L[3], H[0], H[1], H[2], H[3]}
    o[0][VT] = __builtin_amdgcn_mfma_f32_16x16x32_bf16(pa[0][0], PK(fa[0], fa[1]), o[0][VT], 0, 0, 0);
    o[1][VT] = __builtin_amdgcn_mfma_f32_16x16x32_bf16(pa[1][0], PK(fa[0], fa[1]), o[1][VT], 0, 0, 0);
    o[0][VT] = __builtin_amdgcn_mfma_f32_16x16x32_bf16(pa[0][1], PK(fa[2], fa[3]), o[0][VT], 0, 0, 0);
    o[1][VT] = __builtin_amdgcn_mfma_f32_16x16x32_bf16(pa[1][1], PK(fa[2], fa[3]), o[1][VT], 0, 0, 0);
#undef PK
    SBAR();
    pv16_step<NVT, VRSB, DP, VT + 1>(o, vb, pa, f);
  }
}
template <int NVT, int VRSB, int DP, int VT> __device__ __forceinline__ void pv16_pro(int vb, s16x4 (&f)[DP + 1][4]) { if constexpr (VT < DP) { pv16_ld<VT, VRSB>(f[VT], vb); pv16_pro<NVT, VRSB, DP, VT + 1>(vb, f); } }
template <int NVT, int VRSB, int VT> __device__ __forceinline__ void pv16_plain(f32x4 (&o)[2][NVT], int vb, const bf16x8 (&pa)[2][2]) {
  if constexpr (VT < NVT) {
    s16x4 fa[4]; pv16_ld<VT, VRSB>(fa, vb); asm volatile("s_waitcnt lgkmcnt(0)" ::: "memory"); SBAR();
#define PK(L, H) (bf16x8){L[0], L[1], L[2], L[3], H[0], H[1], H[2], H[3]}
    o[0][VT] = __builtin_amdgcn_mfma_f32_16x16x32_bf16(pa[0][0], PK(fa[0], fa[1]), o[0][VT], 0, 0, 0);
    o[1][VT] = __builtin_amdgcn_mfma_f32_16x16x32_bf16(pa[1][0], PK(fa[0], fa[1]), o[1][VT], 0, 0, 0);
    o[0][VT] = __builtin_amdgcn_mfma_f32_16x16x32_bf16(pa[0][1], PK(fa[2], fa[3]), o[0][VT], 0, 0, 0);
    o[1][VT] = __builtin_amdgcn_mfma_f32_16x16x32_bf16(pa[1][1], PK(fa[2], fa[3]), o[1][VT], 0, 0, 0);
#undef PK
    pv16_plain<NVT, VRSB, VT + 1>(o, vb, pa);
  }
}
template <int NVT, int VRSB> __device__ __forceinline__ void pv16(f32x4 (&o)[2][NVT], int vb, const bf16x8 (&pa)[2][2]) {
  if constexpr (NVT <= 16) { constexpr int DP = NVT <= 8 ? 2 : 1; s16x4 f[DP + 1][4]; pv16_pro<NVT, VRSB, DP, 0>(vb, f); pv16_step<NVT, VRSB, DP, 0>(o, vb, pa, f); }
  else pv16_plain<NVT, VRSB, 0>(o, vb, pa);
}

template <int VT, int KB, int VRSB> __device__ __forceinline__ void pvh_ld(s16x4 (&f)[2], int vb) { f[0] = tr16<(32 * KB) * VRSB + VT * 32>(vb); f[1] = tr16<(32 * KB + 16) * VRSB + VT * 32>(vb); }
template <int NVT, int VRSB, int KB, int DH, int VT> __device__ __forceinline__ void pvh_pro(int vb, s16x4 (&f)[DH + 1][2]) { if constexpr (VT < DH && VT < NVT) { pvh_ld<VT, KB, VRSB>(f[VT], vb); pvh_pro<NVT, VRSB, KB, DH, VT + 1>(vb, f); } }
template <int NVT, int VRSB, int KB, int DH, bool EXPS, int VT> __device__ __forceinline__ void pvh_step(f32x4 (&o)[2][NVT], int vb, const bf16x8 (&pa)[2][2], s16x4 (&f)[DH + 1][2], f32x4 (&s)[4][2]) {
  if constexpr (VT < NVT) {
    if constexpr (VT + DH < NVT) pvh_ld<VT + DH, KB, VRSB>(f[(VT + DH) % (DH + 1)], vb);
    lgkm_wait<2 * ((NVT - 1 - VT) < DH ? (NVT - 1 - VT) : DH)>(); SBAR();
    s16x4 (&fa)[2] = f[VT % (DH + 1)];
    const bf16x8 vf = (bf16x8){fa[0][0], fa[0][1], fa[0][2], fa[0][3], fa[1][0], fa[1][1], fa[1][2], fa[1][3]};
    o[0][VT] = __builtin_amdgcn_mfma_f32_16x16x32_bf16(pa[0][KB], vf, o[0][VT], 0, 0, 0);
    o[1][VT] = __builtin_amdgcn_mfma_f32_16x16x32_bf16(pa[1][KB], vf, o[1][VT], 0, 0, 0);
    if constexpr (EXPS) { constexpr int EPS = 16 / NVT;
#pragma unroll
      for (int e = 0; e < EPS; ++e) { constexpr int dummy = 0; (void)dummy; const int idx = VT * EPS + e, kt = 2 + (idx >> 3), qt = (idx >> 2) & 1, r = idx & 3; s[kt][qt][r] = __builtin_amdgcn_exp2f(s[kt][qt][r]); } }
    SBAR();
    pvh_step<NVT, VRSB, KB, DH, EXPS, VT + 1>(o, vb, pa, f, s);
  }
}
__device__ __forceinline__ void cvt_pa(const f32x4 (&s)[4][2], bf16x8 (&pa)[2][2], int kb) {
#pragma unroll
  for (int qt = 0; qt < 2; ++qt) { const f32x4 a = s[2 * kb][qt], b = s[2 * kb + 1][qt];
    u32x4 w = {cvtpk(a[0], a[1]), cvtpk(a[2], a[3]), cvtpk(b[0], b[1]), cvtpk(b[2], b[3])}; pa[qt][kb] = *reinterpret_cast<bf16x8*>(&w); }
}

template <int DK, int DV, int LDQ, int LDK, int LDV, int LDO, typename TOut, bool PIPE, bool QL, bool VS>
__device__ __forceinline__ void attn_body16(const bf16_t* Qb, const bf16_t* Kh, const bf16_t* Vh, TOut* Ob, int seq, char* lds) {
  static_assert(!(PIPE && VS), "the pipelined loop needs two V buffers");
  constexpr int NVT = DV / 16, VRSB = DV * 2 + 32, NVB = VS ? 1 : 2;
  constexpr int KPR = DK / 8, KP = 64 * KPR / 512, VPR = DV / 8, VP = 64 * VPR / 512;
  constexpr size_t SHM_V = KVBLK * VRSB, SHM_K = KVBLK * DK * 2;
  constexpr float SCALE = (DK == 128) ? 0.08838834764831845f : 0.07216878364870323f;
  constexpr float C = SCALE * 1.4426950408889634f, THR_S = THR / SCALE;
  const int tid = fresh_tid(), wid = tid >> 6, lane = tid & 63, c = lane & 15, g = lane >> 4;
  char* V_lds = lds; char* K_lds = lds + NVB * SHM_V;
  char* Q_lds = lds + NVB * SHM_V + 2 * SHM_K + (size_t)wid * (QBLK * DK * 2);
  float* ws = (float*)(lds + NVB * SHM_V + 2 * SHM_K + (QL ? (size_t)NW * QBLK * DK * 2 : 0)) + wid * 64; float* li_l = ws; float* al_l = ws + 32;
  float m_reg[2] = {-1e30f, -1e30f}, lp[2] = {0.f, 0.f}; f32x4 o[2][NVT]; bf16x8 qr[QL ? 1 : 2][QL ? 1 : DK / 32];
#pragma unroll
  for (int qt = 0; qt < 2; ++qt)
#pragma unroll
    for (int vt = 0; vt < NVT; ++vt) o[qt][vt] = (f32x4){0.f, 0.f, 0.f, 0.f};
#pragma unroll
  for (int qt = 0; qt < 2; ++qt)
#pragma unroll
    for (int ks = 0; ks < DK / 32; ++ks) { const bf16x8 qv = *reinterpret_cast<const bf16x8*>(Qb + (long)(wid * QBLK + qt * 16 + c) * LDQ + ks * 32 + g * 8);
      if constexpr (QL) { *reinterpret_cast<bf16x8*>(Q_lds + (qt * 16 + c) * (DK * 2) + (((ks * 32 + g * 8) * 2) ^ ((c & 7) << 4))) = qv; if (qt == 0 && ks == 0) qr[0][0] = qv; } else qr[qt][ks] = qv; }
#define KROW(q) ((tid + 512 * (q)) / KPR)
#define KC8(q) ((tid + 512 * (q)) % KPR)
#define VROW(q) ((tid + 512 * (q)) / VPR)
#define VC8(q) ((tid + 512 * (q)) % VPR)
  const int vb0 = (int)(uintptr_t)V_lds + (4 * g + (c >> 2)) * VRSB + (c & 3) * 8;
  struct { bf16x8 vs[VP], ks[PIPE ? KP : 1]; } sr_;
  const int widu = __builtin_amdgcn_readfirstlane(wid);
#define SLOAD(k0) do { const char* _vb = (const char*)Vh + (size_t)(k0) * (LDV * 2); const char* _kb = (const char*)Kh + (size_t)(k0) * (LDK * 2); \
    _Pragma("unroll") for (int _q = 0; _q < VP; ++_q) sr_.vs[_q] = *reinterpret_cast<const bf16x8*>(_vb + (unsigned)(VROW(_q) * LDV + VC8(_q) * 8) * 2u); \
    _Pragma("unroll") for (int _q = 0; _q < KP; ++_q) sr_.ks[_q] = *reinterpret_cast<const bf16x8*>(_kb + (unsigned)(KROW(_q) * LDK + KC8(_q) * 8) * 2u); } while (0)
#define SWRITE2(bv, b) do { _Pragma("unroll") for (int _q = 0; _q < VP; ++_q) *(bf16x8*)(V_lds + (bv) * SHM_V + VROW(_q) * VRSB + VC8(_q) * 16) = sr_.vs[_q]; \
    _Pragma("unroll") for (int _q = 0; _q < KP; ++_q) *(bf16x8*)(K_lds + (b) * SHM_K + KROW(_q) * (DK * 2) + ((KC8(_q) * 16) ^ ((KROW(_q) & 7) << 4))) = sr_.ks[_q]; } while (0)
#define SWRITE(b) SWRITE2(b, b)
#define VLOAD(k0) do { const char* _vb = (const char*)Vh + (size_t)(k0) * (LDV * 2); \
    _Pragma("unroll") for (int _q = 0; _q < VP; ++_q) sr_.vs[_q] = *reinterpret_cast<const bf16x8*>(_vb + (unsigned)(VROW(_q) * LDV + VC8(_q) * 8) * 2u); } while (0)
#define VWRITE(bv) do { _Pragma("unroll") for (int _q = 0; _q < VP; ++_q) *(bf16x8*)(V_lds + (bv) * SHM_V + VROW(_q) * VRSB + VC8(_q) * 16) = sr_.vs[_q]; } while (0)
#define KDMA(k0, b) do { const char* _kb = (const char*)Kh + (size_t)(k0) * (LDK * 2); \
    _Pragma("unroll") for (int _q = 0; _q < KP; ++_q) { const int _r = KROW(_q), _c = KC8(_q) ^ (_r & 7); \
      __builtin_amdgcn_global_load_lds((const unsigned*)(_kb + (unsigned)(_r * LDK + _c * 8) * 2u), (LAS unsigned*)(unsigned)((unsigned)(uintptr_t)K_lds + (unsigned)((b) * SHM_K) + (unsigned)((widu * 64 + 512 * _q) * 16)), 16, 0, 0); } } while (0)
#define SWAIT() asm volatile("s_waitcnt vmcnt(0)" ::: "memory")
#define QKT(S, KS) do { if constexpr (QL) qkt16l<DK>(S, KS, Q_lds, c, g); else qkt16<DK>(S, KS, (const bf16x8 (&)[2][DK / 32])qr, c, g); } while (0)
#define RESC(a) do { if (__any((a)[0] < 1.f || (a)[1] < 1.f)) { if (g == 0) { al_l[c] = (a)[0]; al_l[16 + c] = (a)[1]; } asm volatile("s_waitcnt lgkmcnt(0)" ::: "memory"); \
    _Pragma("unroll") for (int qt = 0; qt < 2; ++qt) _Pragma("unroll") for (int r = 0; r < 4; ++r) { const float f = al_l[qt * 16 + 4 * g + r]; \
      _Pragma("unroll") for (int vt = 0; vt < NVT; ++vt) o[qt][vt][r] *= f; } } } while (0)
  bf16x8 pa[2][2]; const int NT = seq / KVBLK;
  if constexpr (PIPE) {
    f32x4 sA[4][2], sB[4][2]; float alA[2], alB[2];
    SLOAD(0); asm volatile("s_waitcnt vmcnt(0)" ::: "memory"); SWRITE(0); __syncthreads();
    QKT(sA, K_lds); partialSM16(sA, m_reg, alA, C, THR_S);
    SLOAD(KVBLK);
    SWAIT(); SWRITE(1); __syncthreads();
    for (int j = 1; j + 1 < NT; j += 2) {
      SLOAD((j + 1) * KVBLK); SBAR(); QKT(sB, K_lds + SHM_K); SBAR();
      finishSM16(sA, alA, lp, pa); SBAR();
      pv16<NVT, VRSB>(o, vb0, pa); partialSM16(sB, m_reg, alB, C, THR_S);
      __syncthreads(); SWAIT(); SWRITE(0);
      RESC(alB); __syncthreads();
      SLOAD((j + 2) * KVBLK); SBAR(); QKT(sA, K_lds); SBAR();
      finishSM16(sB, alB, lp, pa); SBAR();
      pv16<NVT, VRSB>(o, vb0 + (int)SHM_V, pa); partialSM16(sA, m_reg, alA, C, THR_S);
      __syncthreads(); SWAIT(); SWRITE(1);
      RESC(alA); __syncthreads();
    }
    SBAR(); QKT(sB, K_lds + SHM_K); SBAR();
    finishSM16(sA, alA, lp, pa); SBAR();
    pv16<NVT, VRSB>(o, vb0, pa); partialSM16(sB, m_reg, alB, C, THR_S);
    __syncthreads(); RESC(alB);
    finishSM16(sB, alB, lp, pa); SBAR();
    pv16<NVT, VRSB>(o, vb0 + (int)SHM_V, pa);
  } else {
    f32x4 s[4][2]; float al[2];
    VLOAD(0); KDMA(0, 0); asm volatile("s_waitcnt vmcnt(0)" ::: "memory"); VWRITE(0); __syncthreads();
    for (int j = 0; j < NT; ++j) {
      const int bsel = j & 1, vsel = VS ? 0 : bsel;
      if (j + 1 < NT) { VLOAD((j + 1) * KVBLK); KDMA((j + 1) * KVBLK, bsel ^ 1); }
      SBAR(); QKT(s, K_lds + bsel * SHM_K);
      partialSM16(s, m_reg, al, C, THR_S);
      RESC(al);
      constexpr int DH = 3; s16x4 pvf[DH + 1][2]; const int vbt = vb0 + vsel * (int)SHM_V;
      pvh_pro<NVT, VRSB, 0, DH, 0>(vbt, pvf); SBAR();
      cvt_pa(s, pa, 0); SBAR();
      pvh_step<NVT, VRSB, 0, DH, true, 0>(o, vbt, pa, pvf, s);
      pvh_pro<NVT, VRSB, 1, DH, 0>(vbt, pvf); SBAR();
#pragma unroll
      for (int qt = 0; qt < 2; ++qt) { float ps = 0.f;
#pragma unroll
        for (int kt = 0; kt < 4; ++kt) ps += (s[kt][qt][0] + s[kt][qt][1]) + (s[kt][qt][2] + s[kt][qt][3]);
        lp[qt] = lp[qt] * al[qt] + ps; }
      cvt_pa(s, pa, 1); SBAR();
      pvh_step<NVT, VRSB, 1, DH, false, 0>(o, vbt, pa, pvf, s);
      if constexpr (VS) {
        asm volatile("s_waitcnt vmcnt(0)" ::: "memory");
        __syncthreads();
        if (j + 1 < NT) VWRITE(0);
      } else if (j + 1 < NT) { asm volatile("s_waitcnt vmcnt(0)" ::: "memory"); VWRITE(bsel ^ 1); }
      __syncthreads();
    }
  }
  { const float l0 = xsum4(lp[0]), l1 = xsum4(lp[1]); if (g == 0) { li_l[c] = l0; li_l[16 + c] = l1; } }
  asm volatile("s_waitcnt lgkmcnt(0)" ::: "memory");
  { constexpr int ESZ = (int)sizeof(TOut), RS = 272, CP = 256 / ESZ, NVTP = CP / 16, NPASS = DV / CP;
    LAS char* stg = (LAS char*)(unsigned)((unsigned)(uintptr_t)lds + (unsigned)wid * (32u * RS));
    float rl[2][4];
#pragma unroll
    for (int qt = 0; qt < 2; ++qt)
#pragma unroll
      for (int r = 0; r < 4; ++r) rl[qt][r] = __builtin_amdgcn_rcpf(li_l[qt * 16 + 4 * g + r]);
    TOut* Ow = Ob + (long)(wid * QBLK) * LDO;
#pragma unroll
    for (int pass = 0; pass < NPASS; ++pass) {
#pragma unroll
      for (int qt = 0; qt < 2; ++qt)
#pragma unroll
        for (int r = 0; r < 4; ++r)
#pragma unroll
          for (int v = 0; v < NVTP; ++v) { const float val = o[qt][pass * NVTP + v][r] * rl[qt][r]; LAS char* p = stg + (qt * 16 + 4 * g + r) * RS + (v * 16 + c) * ESZ;
            if constexpr (ESZ == 2) *(LAS unsigned short*)p = (unsigned short)cvtpk(val, 0.f); else *(LAS float*)p = val; }
#pragma unroll
      for (int i = 0; i < 8; ++i) { const int row = i * 4 + (lane >> 4), ch = lane & 15;
        const u32x4 w = *(const LAS u32x4*)(stg + row * RS + ch * 16);
        *(u32x4*)((char*)(Ow + (long)row * LDO + pass * CP) + ch * 16) = w; }
    }
  }
#undef SLOAD
#undef SWRITE
#undef SWRITE2
#undef VLOAD
#undef VWRITE
#undef KDMA
#undef SWAIT
#undef RESC
#undef QKT
#undef KROW
#undef KC8
#undef VROW
#undef VC8
}
}

struct Args { const float* in[27]; int s_lo, s_hi; };
enum { I_X = 0, I_C, I_CTX, I_CCTX, I_ADAW, I_ADAB, I_WIN, I_QN, I_WUQ, I_KVN, I_WUKV, I_SLNG, I_SLNB, I_SW, I_SB, I_DLAM, I_DSUB, I_WBR, I_WOUT, I_LN1G, I_LN1B, I_WGU, I_WDN, I_LN2G, I_LN2B, I_OUT_, I_WS_ };

struct RowId { int off; __device__ __forceinline__ int operator()(int n) const { return off + n; } };
struct RowGU { __device__ __forceinline__ int operator()(int n) const { const int up = n >= FF, j = up ? n - FF : n; return (j >> 7) * 256 + up * 128 + (j & 127); } };
struct RowWin { __device__ __forceinline__ int operator()(int n) const {
    if (n < 1024) return n;
    if (n < 1088) { const int r = n - 1024, a = r >> 5, wh = (r >> 4) & 1, i = r & 15; return NKR + a * 32 + 2 * i + wh; }
    if (n < 3136) return n - 64;
    if (n < 5184) { const int r = n - 3136, blk = r >> 7, d = r & 127, a = d >> 6, wh = (d >> 5) & 1, i = d & 31; return NDQ + blk * 128 + a * 64 + 2 * i + wh; }
    return n - 64; } };
struct RowUQ { __device__ __forceinline__ int operator()(int n) const { const int h = n / 192, d = n - h * 192; if (d < 128) return n;
    const int r = d - 128, a = r >> 5, wh = (r >> 4) & 1, i = r & 15; return h * 192 + 128 + a * 32 + 2 * i + wh; } };
struct RowUKV { __device__ __forceinline__ int operator()(int n) const { const int h = n >> 8, d = n & 255; return d < 128 ? h * 128 + d : 1024 + h * 128 + (d - 128); } };
template <class RowMap>
__device__ __forceinline__ void transpose_item(const float* W, int K, int N, int ldw, bf16_t* WT, const RowMap& rm, LAS float* scr, int item, int lane, const float* kscale = nullptr) {
    const int nblk = N / 64, kb = item / nblk, nb = item % nblk, k0 = 64 * kb, n0 = 64 * nb;
    f32x4 v[16]; float ksc[16];
#pragma unroll
    for (int i = 0; i < 16; ++i) { const int kk = 4 * i + (lane >> 4), c4 = (lane & 15) * 4;
        v[i] = *(const f32x4*)(W + (size_t)(k0 + kk) * ldw + n0 + c4); ksc[i] = kscale ? kscale[k0 + kk] : 1.0f; }
    __builtin_amdgcn_sched_barrier(0);
#pragma unroll
    for (int i = 0; i < 16; ++i) { const int kk = 4 * i + (lane >> 4), c4 = (lane & 15) * 4; const f32x4 w = kscale ? v[i] * ksc[i] : v[i];
        scr[kk * 65 + c4] = w[0]; scr[kk * 65 + c4 + 1] = w[1]; scr[kk * 65 + c4 + 2] = w[2]; scr[kk * 65 + c4 + 3] = w[3]; }
    asm volatile("s_waitcnt lgkmcnt(0)" ::: "memory");
    const int c = lane & 7;
#pragma unroll
    for (int j = 0; j < 8; ++j) { const int n = (lane >> 3) + 8 * j; const LAS float* s = scr + (8 * c) * 65 + n;
        u32x4 o; o.x = pk2(s[0 * 65], s[1 * 65]); o.y = pk2(s[2 * 65], s[3 * 65]); o.z = pk2(s[4 * 65], s[5 * 65]); o.w = pk2(s[6 * 65], s[7 * 65]);
        *(u32x4*)(WT + (size_t)rm(n0 + n) * K + k0 + 8 * c) = o; }
    asm volatile("s_waitcnt lgkmcnt(0)" ::: "memory");
}

template <int NP> __device__ __forceinline__ void sum_parts(const bf16_t* PART, bf16_t* MIX, int lane, int gw, int NGW) {
    for (int tp = 8192 + gw; tp < T / 2; tp += NGW)
#pragma unroll 1
    for (int rr = 0; rr < 2; ++rr) { const int r = 2 * (tp - 8192) + rr;
        u32x4 w[NP][4];
#pragma unroll
        for (int s = 0; s < NP; ++s)
#pragma unroll
            for (int i = 0; i < 4; ++i) w[s][i] = *(const u32x4*)(PART + ((size_t)s * 1024 + r) * LDM + (lane + 64 * i) * 8);
#pragma unroll
        for (int i = 0; i < 4; ++i) { float a[8] = {0.f, 0.f, 0.f, 0.f, 0.f, 0.f, 0.f, 0.f};
#pragma unroll
            for (int s = 0; s < NP; ++s) { float f[8]; unpack8(w[s][i], f);
#pragma unroll
                for (int e = 0; e < 8; ++e) a[e] += f[e]; }
            *(u32x4*)(MIX + (size_t)(64 * 256 + r) * LDM + (lane + 64 * i) * 8) = pack8(a); }
    }
}
template <int WHICH>
__device__ __forceinline__ void ln_phase(const Args& args, int l, const float* mod_l, float* H, bf16_t* MIX, const bf16_t* PART, bf16_t* XM, int lane, int gw, int NGW) {
    if (l < DEPTH - 1) { if (WHICH == 0) sum_parts<8>(PART, MIX, lane, gw, NGW); else sum_parts<4>(PART, MIX, lane, gw, NGW);
        __builtin_amdgcn_fence(__ATOMIC_SEQ_CST, "workgroup"); }

    const float* lg = args.in[(WHICH ? I_LN2G : I_LN1G)] + (size_t)l * DM; const float* lb = args.in[(WHICH ? I_LN2B : I_LN1B)] + (size_t)l * DM;
    for (int tp = gw; tp < T / 2; tp += NGW) {
        const int t = 2 * tp, b = t / TPB, j = t - b * TPB, mrow = j < CTXL ? 4 : b;
        if (l == DEPTH - 1 && j < CTXL) continue;
        const float* mr = mod_l + (size_t)mrow * 6 * DM; const float* gate = mr + (WHICH ? 5 : 2) * DM;
        const float* hin = (WHICH == 0 && l == 0) ? (j < CTXL ? args.in[I_CTX] + ((size_t)b * CTXL + j) * DM : args.in[I_X] + ((size_t)b * SEQ + (j - CTXL)) * DM) : H + (size_t)t * DM;
        f32x4 v[2][8]; float sum0 = 0.f, sum1 = 0.f;
#pragma unroll
        for (int hb = 0; hb < 2; ++hb) {
            f32x4 gt[4], hv[2][4]; u32x2 mw[2][4];
#pragma unroll
            for (int i4 = 0; i4 < 4; ++i4) { const int d = lane * 4 + 256 * (hb * 4 + i4); gt[i4] = *(const f32x4*)(gate + d);
#pragma unroll
                for (int r = 0; r < 2; ++r) { mw[r][i4] = *(const u32x2*)(MIX + (size_t)(t + r) * LDM + d); hv[r][i4] = *(const f32x4*)(hin + (size_t)r * DM + d); } }
            __builtin_amdgcn_sched_barrier(0);
#pragma unroll
            for (int i4 = 0; i4 < 4; ++i4) { const int i = hb * 4 + i4;
#pragma unroll
                for (int r = 0; r < 2; ++r) { const u32x2 w = mw[r][i4];
                    const f32x4 mx = {__uint_as_float(w.x << 16), __uint_as_float(w.x & 0xffff0000u), __uint_as_float(w.y << 16), __uint_as_float(w.y & 0xffff0000u)};
                    v[r][i] = hv[r][i4] * ALPHA + gt[i4] * mx; }
                sum0 += (v[0][i][0] + v[0][i][1]) + (v[0][i][2] + v[0][i][3]); sum1 += (v[1][i][0] + v[1][i][1]) + (v[1][i][2] + v[1][i][3]); }
            __builtin_amdgcn_sched_barrier(0);
        }
        const float mean0 = wave_sum(sum0, lane) * (1.0f / DM), mean1 = wave_sum(sum1, lane) * (1.0f / DM); float sq0 = 0.f, sq1 = 0.f;
#pragma unroll
        for (int i = 0; i < 8; ++i) { v[0][i] = v[0][i] - mean0; v[1][i] = v[1][i] - mean1;
            sq0 += (v[0][i][0] * v[0][i][0] + v[0][i][1] * v[0][i][1]) + (v[0][i][2] * v[0][i][2] + v[0][i][3] * v[0][i][3]);
            sq1 += (v[1][i][0] * v[1][i][0] + v[1][i][1] * v[1][i][1]) + (v[1][i][2] * v[1][i][2] + v[1][i][3] * v[1][i][3]); }
        const float rstd[2] = {rsqrtf(wave_sum(sq0, lane) * (1.0f / DM) + EPS), rsqrtf(wave_sum(sq1, lane) * (1.0f / DM) + EPS)};
#pragma unroll
        for (int hb = 0; hb < 2; ++hb) {
            f32x4 g4[4], b4[4], ms[4], ma[4];
#pragma unroll
            for (int i4 = 0; i4 < 4; ++i4) { const int d = lane * 4 + 256 * (hb * 4 + i4);
                g4[i4] = *(const f32x4*)(lg + d); b4[i4] = *(const f32x4*)(lb + d); ms[i4] = (f32x4){0.f, 0.f, 0.f, 0.f}; ma[i4] = ms[i4];
                if (WHICH == 0) { ms[i4] = *(const f32x4*)(mr + 4 * DM + d); ma[i4] = *(const f32x4*)(mr + 3 * DM + d); }
                else if (l < DEPTH - 1) { const float* mn = mr + 5 * 6 * DM; ms[i4] = *(const f32x4*)(mn + DM + d); ma[i4] = *(const f32x4*)(mn + d); } }
            __builtin_amdgcn_sched_barrier(0);
#pragma unroll
            for (int i4 = 0; i4 < 4; ++i4) { const int i = hb * 4 + i4, d = lane * 4 + 256 * i;
#pragma unroll
                for (int r = 0; r < 2; ++r) {
                    const f32x4 y = v[r][i] * rstd[r] * g4[i4] + b4[i4];
                    if (WHICH == 0 || l < DEPTH - 1) { *(f32x4*)(H + (size_t)(t + r) * DM + d) = y;
                        const f32x4 x2 = y * (ms[i4] + 1.0f) + ma[i4]; u32x2 w; w.x = pk2(x2[0], x2[1]); w.y = pk2(x2[2], x2[3]); *(u32x2*)(XM + (size_t)(t + r) * DM + d) = w; }
                    else *(f32x4*)((float*)args.in[I_OUT_] + ((size_t)b * SEQ + (j + r - CTXL)) * DM + d) = y; } }
            __builtin_amdgcn_sched_barrier(0);
        }
    }
}

__global__ void __launch_bounds__(512, 2) mk_fwd(Args args) {
    extern __shared__ __attribute__((aligned(16))) unsigned char lds[];
    const int G = gridDim.x, NGW = G * 8;
#define FRESH() const int tid = fresh_tid(), lane = tid & 63, wave = __builtin_amdgcn_readfirstlane(tid >> 6), gw = blockIdx.x * 8 + wave; (void)lane; (void)wave; (void)gw; PTRS(); const float* mod_l = MOD + (size_t)l * 5 * 6 * DM; (void)mod_l
    unsigned char* ws0 = (unsigned char*)args.in[I_WS_];
#define PTRS() \
    const int zz = fresh_zero(); unsigned char* ws = (unsigned char*)args.in[I_WS_ + zz]; (void)ws; \
    float* MOD = (float*)(ws + WS_MOD); \
    float* LAM = (float*)(ws + WS_MISC); \
    float2* TAB128 = (float2*)(ws + WS_MISC + 1024); \
    float2* TAB64 = (float2*)(ws + WS_MISC + 1024 + 16384); \
    bf16_t* WB = (bf16_t*)(ws + WS_WB); \
    float* H = (float*)(ws + WS_H); \
    bf16_t* XM = (bf16_t*)(ws + WS_XM); \
    bf16_t* Z = (bf16_t*)(ws + WS_Z); bf16_t* GNB = (bf16_t*)(ws + WS_GN); \
    bf16_t* QM = (bf16_t*)(ws + WS_B + B_QM); bf16_t* KM = (bf16_t*)(ws + WS_B + B_KM); bf16_t* VM = (bf16_t*)(ws + WS_B + B_VM); \
    float* SSQ = (float*)(ws + WS_B + B_SSQ); float2* SVS = (float2*)(ws + WS_B + B_SVS); \
    bf16_t* Y3 = (bf16_t*)(ws + WS_B + B_Y3); \
    bf16_t* OD = (bf16_t*)(ws + WS_B + B_OD); \
    bf16_t* HH = (bf16_t*)(ws + WS_B); \
    bf16_t* MRG = (bf16_t*)(ws + WS_MRG); \
    bf16_t* MIX = (bf16_t*)(ws + WS_MIX); bf16_t* PART = (bf16_t*)(ws + WS_PART);
    volatile LAS unsigned* MISCW = (volatile LAS unsigned*)((LAS unsigned char*)lds + LDS_MISC);
    if (threadIdx.x < 64) MISCW[threadIdx.x] = 0u;
    __syncthreads();
    if (!MK_PER_PHASE) (void)xcd_barrier_post((unsigned*)(ws0 + WS_CTL) + 4096, MISCW + 8);

    const int s_lo = args.s_lo, s_hi = args.s_hi;
#ifndef PH_MASK
#define PH_MASK 0xfff
#endif
#define IN(s) (((PH_MASK >> ((s) % NPH)) & 1) && s_lo <= (s) && (s) < s_hi)
#ifndef PROBE_DUP
#define PROBE_DUP 0
#endif
#define DUPF(ph) (((PROBE_DUP >> (ph)) & 1) ? 2 : 1)
#define REP(ph) for (int _rep = 0; _rep < (((PROBE_DUP >> (ph)) & 1) ? 2 : 1); ++_rep)
#define SEAM(s) do { if (IN((s) + 1)) { XcdBarrier _b; _b.bar = (unsigned*)((unsigned char*)args.in[I_WS_ + fresh_zero()] + WS_CTL) + 4096; _b.x = xb_xcc_id(); _b.st = (volatile LAS unsigned*)((LAS unsigned char*)lds + LDS_MISC) + 8; xcd_barrier(_b); } } while (0)

    for (int l = 0; l < DEPTH; ++l) {
        const int sb = l * NPH;

        if (IN(sb + PH_CONV)) {
            FRESH();
            LAS float* scr = (LAS float*)((LAS unsigned char*)lds + wave * 16640);
            const float* w_in = args.in[I_WIN + zz] + (size_t)l * DM * INW;
            const float* w_uq = args.in[I_WUQ + zz] + (size_t)l * 512 * 1536;
            const float* w_ukv = args.in[I_WUKV + zz] + (size_t)l * 512 * 2048;
            const float* w_br = args.in[I_WBR + zz] + (size_t)l * 3 * 1024 * DM;
            const float* w_out = args.in[I_WOUT + zz] + (size_t)l * DM * DM;
            const float* w_gu = args.in[I_WGU + zz] + (size_t)l * DM * 2 * FF;
            const float* w_dn = args.in[I_WDN + zz] + (size_t)l * FF * DM;
            constexpr int I_IN = (DM / 64) * (INW / 64), I_UQ = (512 / 64) * (1536 / 64), I_UKV = (512 / 64) * (2048 / 64), I_BR = (1024 / 64) * (DM / 64),
                          I_OUT = (DM / 64) * (DM / 64), I_GU = (DM / 64) * (2 * FF / 64), I_DN = (FF / 64) * (DM / 64);
            constexpr int NITEMS = I_IN + I_UQ + I_UKV + 3 * I_BR + I_OUT + I_GU + I_DN;
            REP(PH_CONV) for (int it = gw; it < NITEMS; it += NGW) {
                int r = it;
                if (r < I_IN) { transpose_item(w_in, DM, INW, INW, WB + WE_IN, RowWin{}, scr, r, lane); continue; } r -= I_IN;
                if (r < I_UQ) { transpose_item(w_uq, 512, 1536, 1536, WB + WE_UQ, RowUQ{}, scr, r, lane, args.in[I_QN + zz] + (size_t)l * 512); continue; } r -= I_UQ;
                if (r < I_UKV) { transpose_item(w_ukv, 512, 2048, 2048, WB + WE_UKV, RowUKV{}, scr, r, lane, args.in[I_KVN + zz] + (size_t)l * 512); continue; } r -= I_UKV;
                if (r < 3 * I_BR) { const int n = r / I_BR; transpose_item(w_br + (size_t)n * 1024 * DM, 1024, DM, DM, WB + WE_BR + (size_t)n * DM * 1024, RowId{0}, scr, r - n * I_BR, lane); continue; } r -= 3 * I_BR;
                if (r < I_OUT) { transpose_item(w_out, DM, DM, DM, WB + WE_OUT, RowId{0}, scr, r, lane); continue; } r -= I_OUT;
                if (r < I_GU) { transpose_item(w_gu, DM, 2 * FF, 2 * FF, WB + WE_GU, RowGU{}, scr, r, lane); continue; } r -= I_GU;
                transpose_item(w_dn, FF, DM, DM, WB + WE_DN, RowId{0}, scr, r, lane);
            }
            for (int i = blockIdx.x * 512 + tid; i < (ZW - NKR - 64) * DM / 8; i += G * 512) *(u32x4*)(WB + WE_IN + (size_t)(NKR + 64) * DM + (size_t)i * 8) = (u32x4){(unsigned)zz, (unsigned)zz, (unsigned)zz, (unsigned)zz};
            if (l == 0) {
                __syncthreads();
                LAS float* sl = (LAS float*)lds;
                LAS float* red = (LAS float*)(lds + 40960);
                for (int i = tid; i < 5 * DM; i += 512) { const int r = i / DM, k = i - r * DM; const float v = r < 4 ? args.in[I_C + zz][r * DM + k] : args.in[I_CCTX + zz][k]; sl[i] = v / (1.0f + __expf(-v)); }
                __syncthreads();
                const int nq = tid & 15, ks = tid >> 4;
                REP(14) for (int unit = blockIdx.x; unit < DEPTH * 192; unit += G) {
                    const int lp = unit / 192, n0 = (unit - lp * 192) * 64;
                    const float* wbase = args.in[I_ADAW + zz] + (size_t)lp * DM * (6 * DM) + n0 + 4 * nq;
                    f32x4 a0 = {0, 0, 0, 0}, a1 = a0, a2 = a0, a3 = a0, a4 = a0;
#pragma unroll 8
                    for (int k = ks * 64; k < ks * 64 + 64; ++k) {
                        const f32x4 w = *(const f32x4*)(wbase + (size_t)k * (6 * DM));
                        a0 += w * sl[k]; a1 += w * sl[DM + k]; a2 += w * sl[2 * DM + k]; a3 += w * sl[3 * DM + k]; a4 += w * sl[4 * DM + k];
                    }
                    *(LAS f32x4*)(red + (ks * 5 + 0) * 64 + 4 * nq) = a0; *(LAS f32x4*)(red + (ks * 5 + 1) * 64 + 4 * nq) = a1; *(LAS f32x4*)(red + (ks * 5 + 2) * 64 + 4 * nq) = a2;
                    *(LAS f32x4*)(red + (ks * 5 + 3) * 64 + 4 * nq) = a3; *(LAS f32x4*)(red + (ks * 5 + 4) * 64 + 4 * nq) = a4;
                    __syncthreads();
                    if (tid < 320) { const int r = tid >> 6, c = tid & 63; float s = args.in[I_ADAB + zz][(size_t)lp * 6 * DM + n0 + c];
                        for (int q = 0; q < 32; ++q) s += red[(q * 5 + r) * 64 + c];
                        MOD[((size_t)lp * 5 + r) * 6 * DM + n0 + c] = s; }
                    __syncthreads();
                }
                if (blockIdx.x == 0 && tid < DEPTH) {
                    const float* lp = args.in[I_DLAM + zz] + (size_t)tid * 4 * 128; float s1 = 0.f, s2 = 0.f;
                    for (int i = 0; i < 128; ++i) { s1 += lp[i] * lp[128 + i]; s2 += lp[256 + i] * lp[384 + i]; }
                    const float li = 0.8f - 0.6f * expf(-0.3f * (float)tid);
                    LAM[tid] = expf(s1) - expf(s2) + li; LAM[4 + tid] = li;
                }
                if (blockIdx.x == 1 % G) {
                    for (int i = tid; i < 64 * 32; i += 512) { const int pos = i >> 5, f = i & 31; const float ang = (float)pos * exp2f(-(float)f * (13.287712379549449f / 32.0f)); TAB128[i] = make_float2(cosf(ang), sinf(ang)); }
                    for (int i = tid; i < 64 * 16; i += 512) { const int pos = i >> 4, f = i & 15; const float ang = (float)pos * exp2f(-(float)f * (13.287712379549449f / 16.0f)); TAB64[i] = make_float2(cosf(ang), sinf(ang)); }
                }
            }
            SEAM(sb + PH_CONV);
        }

        if (l == 0 && IN(sb + PH_INIT)) {
            FRESH();
            REP(PH_INIT) for (int t = gw; t < T; t += NGW) {
                const int b = t / TPB, j = t - b * TPB, mrow = j < CTXL ? 4 : b;
                const float* src = (l == 0) ? (j < CTXL ? args.in[I_CTX + zz] + ((size_t)b * CTXL + j) * DM : args.in[I_X + zz] + ((size_t)b * SEQ + (j - CTXL)) * DM) : H + (size_t)t * DM;
                const float* sh = mod_l + (size_t)mrow * 6 * DM; const float* sc = sh + DM;
#pragma unroll
                for (int i = 0; i < 8; ++i) { const int d = lane * 4 + 256 * i;
                    const f32x4 v = *(const f32x4*)(src + d), a = *(const f32x4*)(sh + d), s = *(const f32x4*)(sc + d);
                    const f32x4 y = v * (s + 1.0f) + a;
                    u32x2 w; w.x = pk2(y[0], y[1]); w.y = pk2(y[2], y[3]); *(u32x2*)(XM + (size_t)t * DM + d) = w; }
            }
            SEAM(sb + PH_INIT);
        }

        if (IN(sb + PH_WIN)) {
            FRESH();
            pg8::Gemm g{XM, WB + WE_IN, T, ZW, DM, DM, DM, 0, 0}; pg8::StaticOrder S; S.init(T, ZW, G, (int)blockIdx.x, 1, 1, 0, 4);
            pg8::EpiWin E{Z, GNB, KM, SSQ, SVS, TAB128, TAB64};
            REP(PH_WIN) pg8::gemm_phase<pg8::EpiWin, pg8::StaticOrder>((LAS unsigned char*)lds, g, S, E);
            SEAM(sb + PH_WIN);
        }

        if (IN(sb + PH_UP)) {
            FRESH();
            REP(PH_UP) {
            if ((int)blockIdx.x >= G - 64) {
                const bf16_t* Wkr = WB + WE_IN + (size_t)NKR * DM; const int l15 = lane & 15, l4 = lane >> 4;
                const int r0 = 64 * 256 + ((int)blockIdx.x - (G - 64)) * 16; const bf16_t* ap = XM + (size_t)(r0 + l15) * DM + wave * 256 + l4 * 8; const bf16_t* bp = Wkr + (size_t)l15 * DM + wave * 256 + l4 * 8;
                f32x4 acc[4] = {{0.f, 0.f, 0.f, 0.f}, {0.f, 0.f, 0.f, 0.f}, {0.f, 0.f, 0.f, 0.f}, {0.f, 0.f, 0.f, 0.f}};
#pragma unroll
                for (int kh = 0; kh < 2; ++kh) {
                    bf16x8 a[4], bb[4][4];
#pragma unroll
                    for (int k = 0; k < 4; ++k) { a[k] = *(const bf16x8*)(ap + (kh * 4 + k) * 32);
#pragma unroll
                        for (int nt = 0; nt < 4; ++nt) bb[k][nt] = *(const bf16x8*)(bp + (size_t)nt * 16 * DM + (kh * 4 + k) * 32); }
                    __builtin_amdgcn_sched_barrier(0);
#pragma unroll
                    for (int k = 0; k < 4; ++k)
#pragma unroll
                        for (int nt = 0; nt < 4; ++nt) acc[nt] = __builtin_amdgcn_mfma_f32_16x16x32_bf16(a[k], bb[k][nt], acc[nt], 0, 0, 0);
                    __builtin_amdgcn_sched_barrier(0);
                }
                LAS f32x4* red = (LAS f32x4*)lds;
#pragma unroll
                for (int nt = 0; nt < 4; ++nt) red[(wave * 4 + nt) * 64 + lane] = acc[nt];
                __syncthreads();
                if (wave == 0) {
#pragma unroll
                    for (int nt = 0; nt < 4; ++nt) { f32x4 s = red[nt * 64 + lane];
#pragma unroll
                        for (int w = 1; w < 8; ++w) s += red[(w * 4 + nt) * 64 + lane];
                        acc[nt] = s; }
#pragma unroll
                    for (int r = 0; r < 4; ++r) {
                        const int t = r0 + 4 * l4 + r, j = t - 3 * TPB, sidx = j - CTXL, prow = sidx >> 6, pcol = sidx & 63;
#pragma unroll
                        for (int nt = 0; nt < 4; ++nt) {
                            const float v = acc[nt][r], p = shflx(v, 1, lane);
                            const float2 cs = TAB64[((nt >> 1) ? pcol : prow) * 16 + 8 * (nt & 1) + (l15 >> 1)];
                            const float x1 = (l15 & 1) ? p : v, x2 = (l15 & 1) ? v : p;
                            const float o1 = x1 * cs.x - x2 * cs.y, o2 = x2 * cs.x + x1 * cs.y;
                            if (!(l15 & 1)) { const unsigned w = pk2(o1, o2);
#pragma unroll
                                for (int h = 0; h < 8; ++h) *(unsigned*)(KM + (size_t)t * 1536 + h * 192 + 128 + 16 * nt + l15) = w; }
                        }
                    }
                }
                __syncthreads();
            }
            { pg8::Gemm g{Z + NZQ, WB + WE_UQ, T, 3584, 512, ZS, 512, (size_t)(NZKV - NZQ) * 2, 0}; pg8::StaticOrder S; S.init(T, 3584, G, (int)blockIdx.x); S.pnsplit = 6;
              pg8::EpiUQKV E{pg8::EpiUQ{QM, SSQ, TAB64}, pg8::EpiUKV{KM, VM, SSQ}}; pg8::gemm_phase<pg8::EpiUQKV, pg8::StaticOrder>((LAS unsigned char*)lds, g, S, E); }
            {
                constexpr int LDP = 136, VSTR = 272;
                LAS bf16_t* Wl = (LAS bf16_t*)lds;
                LAS unsigned char* Vr = (LAS unsigned char*)lds + 128 * LDP * 2;
                LAS f32x2* St = (LAS f32x2*)(lds + 128 * LDP * 2 + 128 * VSTR);
                const float* sw = args.in[I_SW + zz] + (size_t)l * 8 * 128 * 128; const float* sbv = args.in[I_SB + zz] + (size_t)l * 8 * 128;
                const float* slg = args.in[I_SLNG + zz] + (size_t)l * 1024; const float* slb = args.in[I_SLNB + zz] + (size_t)l * 1024;
                bf16_t* YS = Y3 + (size_t)T * 1024;
                const int l15 = lane & 15, l4 = lane >> 4, p0 = wave * 16;
                const int vrb = (int)(uintptr_t)(lds + 128 * LDP * 2) + (l4 * 8 + (l15 >> 2)) * VSTR + (l15 & 3) * 8;
                REP(12) for (int unit = G - 1 - (int)blockIdx.x; unit < (T / 128) * 8; unit += G) {
                    const int gi = unit & 7, ch = unit >> 3, t0 = ch * 128;
                    __syncthreads();
                    if (tid < 128) { const float2* sp = SVS + (size_t)(t0 + tid) * 16; float s = 0.f, ss = 0.f;
#pragma unroll
                        for (int i = 0; i < 16; ++i) { const float2 p = sp[i]; s += p.x; ss += p.y; }
                        const float mean = s * (1.0f / 1024.0f), var = fmaxf(ss * (1.0f / 1024.0f) - mean * mean, 0.f);
                        St[tid] = (f32x2){mean, rsqrtf(var + EPS)}; }
                    f32x4 wv[8]; u32x4 zv[4];
#pragma unroll
                    for (int i = 0; i < 8; ++i) { const int idx = tid + 512 * i, p = idx >> 5, q4 = idx & 31; wv[i] = *(const f32x4*)(sw + ((size_t)gi * 128 + p) * 128 + q4 * 4); }
#pragma unroll
                    for (int i = 0; i < 4; ++i) { const int idx = tid + 512 * i, q = idx >> 4, c8 = idx & 15; zv[i] = *(const u32x4*)(Z + (size_t)(t0 + q) * ZS + NSV + gi * 128 + c8 * 8); }
                    const int c8 = tid & 15; const float* gp = slg + gi * 128 + c8 * 8; const float* bp = slb + gi * 128 + c8 * 8;
                    const f32x4 g0 = *(const f32x4*)gp, g1 = *(const f32x4*)(gp + 4), b0 = *(const f32x4*)bp, b1 = *(const f32x4*)(bp + 4);
                    __builtin_amdgcn_sched_barrier(0);
#pragma unroll
                    for (int i = 0; i < 8; ++i) { const int idx = tid + 512 * i, p = idx >> 5, q4 = idx & 31;
                        u32x2 o; o.x = pk2(wv[i][0], wv[i][1]); o.y = pk2(wv[i][2], wv[i][3]); *(LAS u32x2*)(Wl + p * LDP + q4 * 4) = o; }
                    __syncthreads();
#pragma unroll
                    for (int i = 0; i < 4; ++i) { const int idx = tid + 512 * i, q = idx >> 4;
                        float v[8]; unpack8(zv[i], v);
                        const f32x2 st = St[q];
                        float y[8];
#pragma unroll
                        for (int e = 0; e < 8; ++e) y[e] = (v[e] - st.x) * st.y * (e < 4 ? g0[e & 3] : g1[e & 3]) + (e < 4 ? b0[e & 3] : b1[e & 3]);
                        *(LAS u32x4*)(Vr + q * VSTR + c8 * 16) = pack8(y); }
                    __syncthreads();
                    bf16x8 bw[4];
#pragma unroll
                    for (int kk = 0; kk < 4; ++kk) bw[kk] = *(const LAS bf16x8*)(Wl + (p0 + l15) * LDP + kk * 32 + l4 * 8);
                    const int tok = t0 + p0 + l15; const float bsv = sbv[gi * 128 + p0 + l15];
                    u32x2 uus[8];
#pragma unroll
                    for (int cb = 0; cb < 8; ++cb) uus[cb] = *(const u32x2*)(Z + (size_t)tok * ZS + NSU + gi * 128 + cb * 16 + l4 * 4);
                    __builtin_amdgcn_sched_barrier(0);
#define SGU_CB(cb) do { \
                        const s16x4 a0l = att::tr_read<0 * 32 * VSTR + (cb) * 32>(vrb), a0h = att::tr_read<0 * 32 * VSTR + (cb) * 32 + 4 * VSTR>(vrb), a1l = att::tr_read<1 * 32 * VSTR + (cb) * 32>(vrb), a1h = att::tr_read<1 * 32 * VSTR + (cb) * 32 + 4 * VSTR>(vrb); \
                        const s16x4 a2l = att::tr_read<2 * 32 * VSTR + (cb) * 32>(vrb), a2h = att::tr_read<2 * 32 * VSTR + (cb) * 32 + 4 * VSTR>(vrb), a3l = att::tr_read<3 * 32 * VSTR + (cb) * 32>(vrb), a3h = att::tr_read<3 * 32 * VSTR + (cb) * 32 + 4 * VSTR>(vrb); \
                        asm volatile("s_waitcnt lgkmcnt(0)" ::: "memory"); __builtin_amdgcn_sched_barrier(0); \
                        f32x4 acc = {0.f, 0.f, 0.f, 0.f}; \
                        acc = __builtin_amdgcn_mfma_f32_16x16x32_bf16((bf16x8){a0l[0], a0l[1], a0l[2], a0l[3], a0h[0], a0h[1], a0h[2], a0h[3]}, bw[0], acc, 0, 0, 0); \
                        acc = __builtin_amdgcn_mfma_f32_16x16x32_bf16((bf16x8){a1l[0], a1l[1], a1l[2], a1l[3], a1h[0], a1h[1], a1h[2], a1h[3]}, bw[1], acc, 0, 0, 0); \
                        acc = __builtin_amdgcn_mfma_f32_16x16x32_bf16((bf16x8){a2l[0], a2l[1], a2l[2], a2l[3], a2h[0], a2h[1], a2h[2], a2h[3]}, bw[2], acc, 0, 0, 0); \
                        acc = __builtin_amdgcn_mfma_f32_16x16x32_bf16((bf16x8){a3l[0], a3l[1], a3l[2], a3l[3], a3h[0], a3h[1], a3h[2], a3h[3]}, bw[3], acc, 0, 0, 0); \
                        const int cc = gi * 128 + (cb) * 16 + l4 * 4; \
                        const u32x2 uu = uus[cb]; \
                        const float u0 = __uint_as_float(uu.x << 16), u1 = __uint_as_float(uu.x & 0xffff0000u), u2 = __uint_as_float(uu.y << 16), u3 = __uint_as_float(uu.y & 0xffff0000u); \
                        u32x2 o; o.x = pk2(u0 * (acc[0] + bsv), u1 * (acc[1] + bsv)); o.y = pk2(u2 * (acc[2] + bsv), u3 * (acc[3] + bsv)); \
                        *(u32x2*)(YS + (size_t)tok * 1024 + cc) = o; } while (0)
                    SGU_CB(0); SGU_CB(1); SGU_CB(2); SGU_CB(3); SGU_CB(4); SGU_CB(5); SGU_CB(6); SGU_CB(7);
#undef SGU_CB
                }
                __syncthreads();
            }
            }
            SEAM(sb + PH_UP);
        }

        if (IN(sb + PH_ATTN)) {
            FRESH();
            constexpr int NBIG_M = 512, NSM_M = 32;
            bf16_t* YA = Y3;
#ifndef ATT_SEL
#define ATT_SEL 3
#endif
            REP(PH_ATTN) {
            if (ATT_SEL & 1)
            for (int uidx = blockIdx.x; uidx < NBIG_M + (l == DEPTH - 1 ? 0 : 64 + NSM_M); uidx += G) {
                __syncthreads();
                int bh, qb; bool small;
                if (uidx < NBIG_M) { const int c = uidx & 255, i = uidx >> 8; bh = (c & 7) * 2 + ((c >> 3) >> 4) + 16 * i; qb = (c >> 3) & 15; small = false; }
                else { bh = uidx - NBIG_M - 64; qb = 0; small = true; if (bh < 0) continue; }
                const int b = bh >> 3, h = bh & 7; const size_t tk0 = (size_t)b * TPB, tq0 = tk0 + (small ? 0 : CTXL + qb * 256);
                att::attn_body16<192, 128, 1536, 1536, 1024, 1024, bf16_t, false, false, false>(QM + tq0 * 1536 + h * 192, KM + tk0 * 1536 + h * 192, VM + tk0 * 1024 + h * 128,
                                                                            YA + tq0 * 1024 + h * 128, small ? CTXL : TPB, (char*)lds);
            }
            if (ATT_SEL & 2)
            for (int uidx = blockIdx.x; uidx < 512 + (l == DEPTH - 1 ? 0 : 32); uidx += G) {
                __syncthreads();
                int combo, qb; bool small;
                if (uidx < 512) { const int c = uidx & 255, i = uidx >> 8; combo = (c & 7) * 2 + ((c >> 3) >> 4) + 16 * i; qb = (c >> 3) & 15; small = false; }
                else { combo = uidx - 512; qb = 0; small = true; }
                const int mp = combo & 1, h = (combo >> 1) & 3, b = combo >> 3;
                const size_t tk0 = (size_t)b * TPB, tq0 = tk0 + (small ? 0 : CTXL + qb * 256);
                att::attn_body16<128, 256, ZS, ZS, ZS, 1024, bf16_t, false, true, true>(Z + tq0 * ZS + NDQ + h * 256 + mp * 128, Z + tk0 * ZS + NDK + h * 256 + mp * 128, Z + tk0 * ZS + NDV + h * 256,
                                                                                          OD + (size_t)mp * T * 1024 + tq0 * 1024 + h * 256, small ? CTXL : TPB, (char*)lds);
            }
            }
            __syncthreads();
            SEAM(sb + PH_ATTN);
        }

        if (IN(sb + PH_DIFFC)) {
            FRESH();
            const float lam = LAM[l], omli = 1.0f - LAM[4 + l]; const float* sub = args.in[I_DSUB + zz] + (size_t)l * 256;
            bf16_t* YD = Y3 + (size_t)2 * T * 1024;
            f32x4 gsub[4];
#pragma unroll
            for (int i = 0; i < 4; ++i) gsub[i] = *(const f32x4*)(sub + (lane & 15) * 4 + 64 * i) * omli;
            REP(PH_DIFFC) for (int t = gw; t < T; t += NGW) {
                const int h = lane >> 4, c0 = (lane & 15) * 4;
                const bf16_t* o1 = OD + (size_t)t * 1024 + h * 256; const bf16_t* o2 = o1 + (size_t)T * 1024;
                f32x4 d[4], e2[4]; float ss = 0.f;
#pragma unroll
                for (int i = 0; i < 4; ++i) { const u32x2 w1 = *(const u32x2*)(o1 + c0 + 64 * i), w2 = *(const u32x2*)(o2 + c0 + 64 * i);
                    d[i] = (f32x4){__uint_as_float(w1.x << 16), __uint_as_float(w1.x & 0xffff0000u), __uint_as_float(w1.y << 16), __uint_as_float(w1.y & 0xffff0000u)};
                    e2[i] = (f32x4){__uint_as_float(w2.x << 16), __uint_as_float(w2.x & 0xffff0000u), __uint_as_float(w2.y << 16), __uint_as_float(w2.y & 0xffff0000u)}; }
                __builtin_amdgcn_sched_barrier(0);
#pragma unroll
                for (int i = 0; i < 4; ++i) { d[i] = d[i] - e2[i] * lam; ss += d[i][0] * d[i][0] + d[i][1] * d[i][1] + d[i][2] * d[i][2] + d[i][3] * d[i][3]; }
                ss += shflx(ss, 1, lane); ss += shflx(ss, 2, lane); ss += shflx(ss, 4, lane); ss += shflx(ss, 8, lane);
                const float rstd = rsqrtf(ss * (1.0f / 256.0f) + EPS);
#pragma unroll
                for (int i = 0; i < 4; ++i) { const f32x4 y = d[i] * rstd * gsub[i];
                    u32x2 w; w.x = pk2(y[0], y[1]); w.y = pk2(y[2], y[3]); *(u32x2*)(YD + (size_t)t * 1024 + h * 256 + c0 + 64 * i) = w; }
            }
            SEAM(sb + PH_DIFFC);
        }

        if (IN(sb + PH_MERGE)) {
            FRESH();
            pg8::Gemm g{Y3, WB + WE_BR, T, DM, 1024, 1024, 1024, (size_t)T * 1024 * 2, (size_t)DM * 1024 * 2}; pg8::StaticOrder S; S.init(T, DM, G, (int)blockIdx.x, 3, DUPF(PH_MERGE), l == DEPTH - 1);
            if (l < DEPTH - 1 && DUPF(PH_MERGE) == 1 && 512 % G == 0) { S.tailM = 1; S.nM = 64; S.nwg = 512; }
            pg8::EpiMerge E{GNB, MRG, PART, (unsigned*)(ws + WS_CTL) + 65536 + l * 256};
            pg8::gemm_phase<pg8::EpiMerge, pg8::StaticOrder>((LAS unsigned char*)lds, g, S, E);
            SEAM(sb + PH_MERGE);
        }

        if (IN(sb + PH_OUT)) {
            FRESH();
            pg8::Gemm g{MRG, WB + WE_OUT, T, DM, DM, LDM, DM, (size_t)(DM / 8) * 2, (size_t)(DM / 8) * 2}; pg8::StaticOrder S; S.init(T, DM, G, (int)blockIdx.x, 1, DUPF(PH_OUT), l == DEPTH - 1);
            if (l < DEPTH - 1) { S.tailS = 8; S.tailnt = DM / 8 / 64; S.nM = 64; S.nwg = 512; }
            pg8::EpiBf16 E{MIX, LDM, PART};
            pg8::gemm_phase<pg8::EpiBf16, pg8::StaticOrder>((LAS unsigned char*)lds, g, S, E);
            SEAM(sb + PH_OUT);
        }

        if (IN(sb + PH_LN1)) {
            FRESH();
            ln_phase<0>(args, l, mod_l, H, MIX, PART, XM, lane, gw, NGW);
            SEAM(sb + PH_LN1);
        }
        if (IN(sb + PH_GU)) {
            FRESH();
            pg8::Gemm g{XM, WB + WE_GU, T, 2 * FF, DM, DM, DM, 0, 0}; pg8::StaticOrder S; S.init(T, 2 * FF, G, (int)blockIdx.x, 1, 1, l == DEPTH - 1);
            pg8::EpiSwiGlu E{HH};
            REP(PH_GU) pg8::gemm_phase<pg8::EpiSwiGlu, pg8::StaticOrder>((LAS unsigned char*)lds, g, S, E);
            SEAM(sb + PH_GU);
        }
        if (IN(sb + PH_DOWN)) {
            FRESH();
            pg8::Gemm g{HH, WB + WE_DN, T, DM, FF, FF, FF, (size_t)(FF / 4) * 2, (size_t)(FF / 4) * 2}; pg8::StaticOrder S; S.init(T, DM, G, (int)blockIdx.x, 1, DUPF(PH_DOWN), l == DEPTH - 1);
            if (l < DEPTH - 1) { S.tailS = 4; S.tailnt = FF / 4 / 64; S.nM = 64; S.nwg = 512; }
            pg8::EpiBf16 E{MIX, LDM, PART};
            pg8::gemm_phase<pg8::EpiBf16, pg8::StaticOrder>((LAS unsigned char*)lds, g, S, E);
            SEAM(sb + PH_DOWN);
        }
        if (IN(sb + PH_LN2)) {
            FRESH();
            ln_phase<1>(args, l, mod_l, H, MIX, PART, XM, lane, gw, NGW);
        }
    }
#undef IN
#undef SEAM
}

extern "C" void kernel_launch(void* const* d_in, const int* in_sizes, int n_in, void* d_out, int out_size, void* d_ws, size_t ws_size, hipStream_t stream) {
    static int grid = 0;
    if (grid == 0) {
        if (n_in != 25 || out_size != NBATCH * SEQ * DM || ws_size < WS_END) { fprintf(stderr, "kernel_launch: unexpected shapes (n_in %d out %d ws %zu, need ws >= %zu); nothing launched\n", n_in, out_size, ws_size, (size_t)WS_END); grid = -1; return; }
        int dev = 0, cus = 0, per_cu = 0;
        if (hipGetDevice(&dev) != hipSuccess || hipDeviceGetAttribute(&cus, hipDeviceAttributeMultiprocessorCount, dev) != hipSuccess) { grid = -1; return; }
        if (hipFuncSetAttribute((const void*)mk_fwd, hipFuncAttributeMaxDynamicSharedMemorySize, LDS_BYTES) != hipSuccess) { fprintf(stderr, "kernel_launch: hipFuncSetAttribute failed\n"); grid = -1; return; }
        if (hipOccupancyMaxActiveBlocksPerMultiprocessor(&per_cu, (const void*)mk_fwd, 512, LDS_BYTES) != hipSuccess || per_cu < 1) { fprintf(stderr, "kernel_launch: occupancy query says %d\n", per_cu); }
        (void)hipGetLastError();
        grid = cus;
    }
    if (grid < 0) return;
    (void)hipMemsetAsync((char*)d_ws + WS_CTL, 0, CTL_BYTES, stream);
    Args a{};
    for (int i = 0; i < 25; ++i) a.in[i] = (const float*)d_in[i];
    a.in[I_OUT_] = (const float*)d_out; a.in[I_WS_] = (const float*)d_ws;
#if MK_PER_PHASE
    for (int s = 0; s < DEPTH * NPH; ++s) { a.s_lo = s; a.s_hi = s + 1; hipLaunchKernelGGL(mk_fwd, dim3(grid), dim3(512), LDS_BYTES, stream, a); }
#else
    a.s_lo = 0; a.s_hi = DEPTH * NPH; hipLaunchKernelGGL(mk_fwd, dim3(grid), dim3(512), LDS_BYTES, stream, a);
#endif
    const hipError_t le = hipPeekAtLastError();
    if (le != hipSuccess) fprintf(stderr, "kernel_launch: launch failed: %s\n", hipGetErrorName(le));
}
```
